# Optimizing an MI355X kernel written in HIP

```python
import jax, jax.numpy as jnp
from jax import lax
import numpy as np

D_MODEL = 1024
BATCH = 16
SEQ = 4096
DEPTH = 2

HEAD_DIM = 64
N_HEADS = D_MODEL // HEAD_DIM
DILATED_GROUPS = ((128, 1), (512, 4), (2048, 16))
N_GROUPS = len(DILATED_GROUPS)
BAND_BLOCK = 128
ROT_DIM = HEAD_DIM // 4
ROPE_THETA = 500000.0
FOX_BLOCK = 128
D_FF = 2816
N_A_LAYERS = DEPTH // 2
N_B_LAYERS = DEPTH - N_A_LAYERS
HD = N_HEADS * HEAD_DIM
EPS = 1e-6

kernel_name = "yoco_dilated_fox_macaron_trunk"


def rms_norm(x, g):
    xf = x.astype(jnp.float32)
    y = xf * lax.rsqrt(jnp.mean(xf * xf, axis=-1, keepdims=True) + EPS)
    return (y * g.astype(jnp.float32)).astype(x.dtype)


def swiglu(x, w_in, w_out):
    gate, up = jnp.split(x @ w_in, 2, axis=-1)
    return (jax.nn.silu(gate) * up) @ w_out


def rope_partial(x, positions):
    half = ROT_DIM // 2
    inv_freq = ROPE_THETA ** (-jnp.arange(0, ROT_DIM, 2, dtype=jnp.float32) / ROT_DIM)
    ang = positions.astype(jnp.float32)[..., None] * inv_freq
    cos, sin = jnp.cos(ang)[:, :, None, :], jnp.sin(ang)[:, :, None, :]
    xr = x[..., :ROT_DIM].astype(jnp.float32)
    x1, x2 = xr[..., :half], xr[..., half:]
    rot = jnp.concatenate([x1 * cos - x2 * sin, x2 * cos + x1 * sin], axis=-1)
    return jnp.concatenate([rot.astype(x.dtype), x[..., ROT_DIM:]], axis=-1)


def dilated_band_attention(q, k, v, window, dilation):
    b, s, h, dh = q.shape
    n_steps = window // dilation
    span = dilation * BAND_BLOCK
    s_pad = -(-s // span) * span
    seq_len = s_pad // dilation
    nb = seq_len // BAND_BLOCK
    pad = ((0, 0), (0, s_pad - s), (0, 0), (0, 0))

    def to_blocks(t):
        t = jnp.pad(t, pad).reshape(b, seq_len, dilation, h, dh).transpose(0, 2, 1, 3, 4)
        return t.reshape(b, dilation, nb, BAND_BLOCK, h, dh)

    def with_prev(t):
        prev = jnp.pad(t, ((0, 0), (0, 0), (1, 0), (0, 0), (0, 0), (0, 0)))[:, :, :-1]
        return jnp.concatenate([prev, t], axis=3)

    qb = to_blocks(q)
    kk = with_prev(to_blocks(k))
    vv = with_prev(to_blocks(v))
    scores = jnp.einsum('brnqhd,brnkhd->brnhqk', qb, kk).astype(jnp.float32) * (dh ** -0.5)
    qi = jnp.arange(BAND_BLOCK)[:, None]
    kj = jnp.arange(2 * BAND_BLOCK)[None, :]
    dist = qi + BAND_BLOCK - kj
    blk = jnp.arange(nb)[:, None, None]
    valid = (dist >= 0) & (dist <= n_steps) & ((blk > 0) | (kj >= BAND_BLOCK))
    scores = jnp.where(valid[:, None], scores, -jnp.inf)
    lse = jax.nn.logsumexp(scores, axis=-1)
    probs = jnp.exp(scores - lse[..., None])
    out = jnp.einsum('brnhqk,brnkhd->brnqhd', probs.astype(v.dtype), vv)
    out = out.transpose(0, 2, 3, 1, 4, 5).reshape(b, s_pad, h, dh)[:, :s]
    lse = lse.transpose(0, 2, 4, 1, 3).reshape(b, s_pad, h)[:, :s]
    return out, lse


def dilated_mixture_mixer(hn, positions, w_qkv, q_norm, k_norm, w_o):
    b, s, _ = hn.shape
    qkv = (hn @ w_qkv).reshape(b, s, N_GROUPS, 3, N_HEADS, HEAD_DIM)
    outs, lses = [], []
    for g, (window, dilation) in enumerate(DILATED_GROUPS):
        q = rope_partial(rms_norm(qkv[:, :, g, 0], q_norm[g]), positions)
        k = rope_partial(rms_norm(qkv[:, :, g, 1], k_norm[g]), positions)
        o, lse = dilated_band_attention(q, k, qkv[:, :, g, 2], window, dilation)
        outs.append(o.astype(jnp.float32))
        lses.append(lse)
    alpha = jax.nn.softmax(jnp.stack(lses, axis=0), axis=0)
    mixed = jnp.sum(alpha[..., None] * jnp.stack(outs, axis=0), axis=0).astype(hn.dtype)
    return mixed.reshape(b, s, HD) @ w_o


def shared_kv(hn, w_kv, b_f, k_norm):
    b, s, _ = hn.shape
    proj = hn @ w_kv
    k = rms_norm(proj[..., :HD].reshape(b, s, N_HEADS, HEAD_DIM), k_norm)
    v = proj[..., HD:2 * HD].reshape(b, s, N_HEADS, HEAD_DIM)
    log_f = jax.nn.log_sigmoid(proj[..., 2 * HD:].astype(jnp.float32) + b_f.astype(jnp.float32))
    cum = jnp.cumsum(log_f, axis=1)
    return k, v, cum


def forgetting_attention(hn, k, v, cum, w_q, q_norm, w_o):
    b, s, _ = hn.shape
    q = rms_norm((hn @ w_q).reshape(b, s, N_HEADS, HEAD_DIM), q_norm)
    nb = s // FOX_BLOCK
    q_blocks = q.reshape(b, nb, FOX_BLOCK, N_HEADS, HEAD_DIM).transpose(1, 0, 2, 3, 4)
    c_blocks = cum.reshape(b, nb, FOX_BLOCK, N_HEADS).transpose(1, 0, 2, 3)
    ck = cum.transpose(0, 2, 1)[:, :, None, :]
    key_pos = jnp.arange(s)
    scale = HEAD_DIM ** -0.5

    def block(args):
        qb, cb, bi = args
        logits = jnp.einsum('bqhd,bshd->bhqs', qb, k).astype(jnp.float32) * scale
        logits = logits + (cb.transpose(0, 2, 1)[..., None] - ck)
        qpos = bi * FOX_BLOCK + jnp.arange(FOX_BLOCK)
        logits = jnp.where(key_pos[None, :] <= qpos[:, None], logits, -jnp.inf)
        p = jax.nn.softmax(logits, axis=-1)
        return jnp.einsum('bhqs,bshd->bqhd', p.astype(v.dtype), v)

    o = lax.map(block, (q_blocks, c_blocks, jnp.arange(nb)))
    o = o.transpose(1, 0, 2, 3, 4).reshape(b, s, HD)
    return o @ w_o


def setup_inputs(seed: int = 0) -> dict:
    key = jax.random.key(seed)
    ks = jax.random.split(key, 20)
    f32 = jnp.float32

    def nrm(k, shape, fan_in):
        return jax.random.normal(k, shape, f32) * (fan_in ** -0.5)

    def gain(k, shape):
        return 1.0 + 0.05 * jax.random.normal(k, shape, f32)

    x = jax.random.normal(ks[0], (BATCH, SEQ, D_MODEL), f32)
    offset = jax.random.randint(ks[1], (BATCH, 1), 0, 1024, dtype=jnp.int32)
    positions = (jnp.arange(SEQ, dtype=jnp.int32)[None, :] + offset).astype(jnp.int32)
    return {
        "x": x,
        "positions": positions,
        "ffn_norm": gain(ks[2], (DEPTH, 2, D_MODEL)),
        "ffn_w_in": nrm(ks[3], (DEPTH, 2, D_MODEL, 2 * D_FF), D_MODEL),
        "ffn_w_out": nrm(ks[4], (DEPTH, 2, D_FF, D_MODEL), D_FF),
        "mix_norm": gain(ks[5], (DEPTH, D_MODEL)),
        "a_w_qkv": nrm(ks[6], (N_A_LAYERS, D_MODEL, N_GROUPS * 3 * HD), D_MODEL),
        "a_q_norm": gain(ks[7], (N_A_LAYERS, N_GROUPS, HEAD_DIM)),
        "a_k_norm": gain(ks[8], (N_A_LAYERS, N_GROUPS, HEAD_DIM)),
        "a_w_o": nrm(ks[9], (N_A_LAYERS, HD, D_MODEL), HD),
        "kv_norm": gain(ks[10], (D_MODEL,)),
        "kv_w": nrm(ks[11], (D_MODEL, 2 * HD + N_HEADS), D_MODEL),
        "kv_b_f": 0.1 * jax.random.normal(ks[12], (N_HEADS,), f32),
        "kv_k_norm": gain(ks[13], (HEAD_DIM,)),
        "b_w_q": nrm(ks[14], (N_B_LAYERS, D_MODEL, HD), D_MODEL),
        "b_q_norm": gain(ks[15], (N_B_LAYERS, HEAD_DIM)),
        "b_w_o": nrm(ks[16], (N_B_LAYERS, HD, D_MODEL), HD),
    }


def reference(x, positions, ffn_norm, ffn_w_in, ffn_w_out, mix_norm, a_w_qkv, a_q_norm, a_k_norm, a_w_o,
              kv_norm, kv_w, kv_b_f, kv_k_norm, b_w_q, b_q_norm, b_w_o):
    h = x
    k_sh = v_sh = cum_sh = None
    for layer in range(DEPTH):
        if layer == N_A_LAYERS:
            k_sh, v_sh, cum_sh = shared_kv(rms_norm(h, kv_norm), kv_w, kv_b_f, kv_k_norm)
        h = h + 0.5 * swiglu(rms_norm(h, ffn_norm[layer, 0]), ffn_w_in[layer, 0], ffn_w_out[layer, 0])
        hn = rms_norm(h, mix_norm[layer])
        if layer < N_A_LAYERS:
            h = h + dilated_mixture_mixer(hn, positions, a_w_qkv[layer], a_q_norm[layer],
                                          a_k_norm[layer], a_w_o[layer])
        else:
            j = layer - N_A_LAYERS
            h = h + forgetting_attention(hn, k_sh, v_sh, cum_sh, b_w_q[j], b_q_norm[j], b_w_o[j])
        h = h + 0.5 * swiglu(rms_norm(h, ffn_norm[layer, 1]), ffn_w_in[layer, 1], ffn_w_out[layer, 1])
    return h
```

```cpp
#include <hip/hip_runtime.h>
#include <hip/hip_cooperative_groups.h>
#include <cstdio>
#include <cstdint>
#include <cmath>
namespace cg = cooperative_groups;
namespace pg8 {
#define PG8_LAS __attribute__((address_space(3)))
typedef unsigned short bf16_t;
typedef short bf16x8 __attribute__((ext_vector_type(8)));
typedef float f32x4 __attribute__((ext_vector_type(4)));
typedef unsigned u32x4 __attribute__((ext_vector_type(4)));
constexpr int BM = 256, BK = 64, HALF = 128, HTB = HALF * BK * 2  , STAGE_BYTES = 8 * HTB, NXCD = 8, WGM = 8;

__host__ __device__ __forceinline__ int lds_byte(int r, int c) { const int st = (r >> 4) * 2 + (c >> 5), rr = r & 15, cc = c & 31, ob = rr * 64 + cc * 2; return st * 1024 + (ob ^ (((ob >> 9) & 1) << 5)); }
__host__ __device__ __forceinline__ void stage_rc(int b, int& R, int& C) { const int st = b / 1024, sb = b % 1024, swz = sb ^ (((sb >> 9) & 1) << 5); R = (st >> 1) * 16 + swz / 64; C = (st & 1) * 32 + (swz % 64) / 2; }
__host__ __device__ __forceinline__ int perm32(int rho) { const int n = rho >> 4, i = rho & 15; return 8 * (i >> 2) + 4 * n + (i & 3); }

struct Unit { int pm, pn; };
struct Gemm { const bf16_t* A; const bf16_t* Bt; int M, N, K; };

struct StaticOrder {
    int nM, nN, nwg, G, c;
    __host__ __device__ void init(int M, int N, int G_, int c_) { nM = M / BM; nN = N / BM; nwg = nM * nN; G = G_; c = c_; }
    __host__ __device__ bool next(int i, Unit& u) const {
        const long L = (long)i * G + c; if (L >= nwg) return false;
        int wgid = (int)L; { const int q = nwg / NXCD, r = nwg % NXCD, xcd = wgid % NXCD, off = wgid / NXCD; wgid = (xcd < r ? xcd * (q + 1) : r * (q + 1) + (xcd - r) * q) + off; }
        const int nig = WGM * nN, gid = wgid / nig, fm = gid * WGM, gsz = (nM - fm) < WGM ? (nM - fm) : WGM;
        u.pm = fm + ((wgid % nig) % gsz); u.pn = (wgid % nig) / gsz; return true;
    }
    __device__ __forceinline__ void a_ready(const Unit&) const {}
    __device__ __forceinline__ void done(const Unit&) const {}
};

__device__ __forceinline__ unsigned cvt_pk_bf16(float lo, float hi) { unsigned r; asm volatile("v_cvt_pk_bf16_f32 %0, %1, %2" : "=v"(r) : "v"(lo), "v"(hi)); return r; }
typedef float f32x2 __attribute__((ext_vector_type(2)));
__device__ __forceinline__ float swiglu_f(float g2, float u2) { return (g2 * u2) * __builtin_amdgcn_rcpf(1.0f + __builtin_amdgcn_exp2f(-g2)); }
__device__ __forceinline__ float sum_fq(float v) {
    auto a = __builtin_amdgcn_permlane32_swap(__float_as_uint(v), __float_as_uint(v), false, false); v = __uint_as_float(a[0]) + __uint_as_float(a[1]);
    auto b = __builtin_amdgcn_permlane16_swap(__float_as_uint(v), __float_as_uint(v), false, false); return __uint_as_float(b[0]) + __uint_as_float(b[1]);
}
__device__ __forceinline__ float xor16(float v, int fq) {
    auto b = __builtin_amdgcn_permlane16_swap(__float_as_uint(v), __float_as_uint(v), false, false); return __uint_as_float((fq & 1) ? b[0] : b[1]);
}
__device__ __forceinline__ float row_rstd(const float* ss, int row, int fq) {
    const f32x4 v = *(const f32x4*)(ss + (size_t)row * 16 + 4 * fq); float s = (v[0] + v[1]) + (v[2] + v[3]);
    s += __shfl_xor(s, 16); s += __shfl_xor(s, 32);
    return 1.0f / sqrtf(s * (1.0f / 1024.0f) + 1e-6f);
}
__device__ __forceinline__ void ss_prefetch(const float* ss, size_t row0, PG8_LAS float* sl, int wid, int lane) {
    const char* g = (const char*)(ss + row0 * 16) + wid * 2048 + lane * 16; PG8_LAS char* d = (PG8_LAS char*)sl + wid * 2048;
    __builtin_amdgcn_global_load_lds((const unsigned*)g, (PG8_LAS unsigned*)d, 16, 0, 0);
    __builtin_amdgcn_global_load_lds((const unsigned*)(g + 1024), (PG8_LAS unsigned*)(d + 1024), 16, 0, 0);
}
__device__ __forceinline__ void rows_rstd_lds(float (&rs)[2][4], const PG8_LAS float* sl, int rl0, int fq) {
    f32x4 v[2][4];
#pragma unroll
    for (int ai = 0; ai < 2; ++ai)
#pragma unroll
        for (int m = 0; m < 4; ++m) v[ai][m] = *(const PG8_LAS f32x4*)(sl + (rl0 + ai * HALF + m * 16) * 16 + 4 * fq);
#pragma unroll
    for (int ai = 0; ai < 2; ++ai)
#pragma unroll
        for (int m = 0; m < 4; ++m) { float s = (v[ai][m][0] + v[ai][m][1]) + (v[ai][m][2] + v[ai][m][3]); s = sum_fq(s); rs[ai][m] = __builtin_amdgcn_rsqf(s * (1.0f / 1024.0f) + 1e-6f); }
}
__device__ __forceinline__ void rows_rstd(float (&rs)[2][4], const float* ss, int row0, int fq) {
    f32x4 v[2][4];
#pragma unroll
    for (int ai = 0; ai < 2; ++ai)
#pragma unroll
        for (int m = 0; m < 4; ++m) v[ai][m] = *(const f32x4*)(ss + (size_t)(row0 + ai * HALF + m * 16) * 16 + 4 * fq);
#pragma unroll
    for (int ai = 0; ai < 2; ++ai)
#pragma unroll
        for (int m = 0; m < 4; ++m) { float s = (v[ai][m][0] + v[ai][m][1]) + (v[ai][m][2] + v[ai][m][3]); s = sum_fq(s); rs[ai][m] = __builtin_amdgcn_rsqf(s * (1.0f / 1024.0f) + 1e-6f); }
}
struct EpiSwiglu {
    static constexpr bool PERM = true, AFTER_DRAIN = false;
    bf16_t* O; int ldc; const float* ss; PG8_LAS float* sl;
    __device__ __forceinline__ void prefetch(const Unit& u, int wid, int lane) const { ss_prefetch(ss, (size_t)u.pm * BM, sl, wid, lane); }
    __device__ __forceinline__ void operator()(const f32x4 (&acc)[2][2][4][2], const Unit& u, int wr, int wc, int fr, int fq) const {
        const int row0 = u.pm * BM + wr * 64 + fr; const int col0 = u.pn * HALF + wc * 32 + 8 * fq;
        float rsv[2][4]; rows_rstd_lds(rsv, sl, wr * 64 + fr, fq);
#pragma unroll
        for (int ai = 0; ai < 2; ++ai)
#pragma unroll
            for (int m = 0; m < 4; ++m) { bf16_t* rowp = O + (size_t)(row0 + ai * HALF + m * 16) * ldc + col0;
                const float rs = rsv[ai][m];
                const f32x4 g0 = acc[ai][0][m][0] * rs, g1 = acc[ai][0][m][1] * rs, u0 = acc[ai][1][m][0] * rs, u1 = acc[ai][1][m][1] * rs;
                u32x4 w; w.x = cvt_pk_bf16(swiglu_f(g0[0], u0[0]), swiglu_f(g0[1], u0[1])); w.y = cvt_pk_bf16(swiglu_f(g0[2], u0[2]), swiglu_f(g0[3], u0[3]));
                w.z = cvt_pk_bf16(swiglu_f(g1[0], u1[0]), swiglu_f(g1[1], u1[1])); w.w = cvt_pk_bf16(swiglu_f(g1[2], u1[2]), swiglu_f(g1[3], u1[3]));
                *(u32x4*)rowp = w; }
    }
};
struct EpiResF32 {
    static constexpr bool PERM = true, AFTER_DRAIN = false;
    const float* resf; const bf16_t* resb; float* outf; bf16_t* outb; int ldc; float s; float* ss;
    __device__ __forceinline__ void prefetch(const Unit&, int, int) const {}
    __device__ __forceinline__ void operator()(const f32x4 (&acc)[2][2][4][2], const Unit& u, int wr, int wc, int fr, int fq) const {
        const int col0 = u.pn * BM + wc * 32 + 8 * fq;
#pragma unroll
        for (int ai = 0; ai < 2; ++ai) {
            f32x4 rv[4][2][2];
            if (resf) {
#pragma unroll
                for (int m = 0; m < 4; ++m) { const size_t off = (size_t)(u.pm * BM + ai * HALF + wr * 64 + m * 16 + fr) * ldc + col0;
#pragma unroll
                    for (int bj = 0; bj < 2; ++bj)
#pragma unroll
                        for (int n = 0; n < 2; ++n) rv[m][bj][n] = *(const f32x4*)(resf + off + bj * HALF + n * 4); }
            } else {
                u32x4 rb[4][2];
#pragma unroll
                for (int m = 0; m < 4; ++m) { const size_t off = (size_t)(u.pm * BM + ai * HALF + wr * 64 + m * 16 + fr) * ldc + col0;
#pragma unroll
                    for (int bj = 0; bj < 2; ++bj) rb[m][bj] = *(const u32x4*)(resb + off + bj * HALF); }
#pragma unroll
                for (int m = 0; m < 4; ++m)
#pragma unroll
                    for (int bj = 0; bj < 2; ++bj) { const u32x4 w = rb[m][bj];
                        rv[m][bj][0] = (f32x4){__uint_as_float(w.x << 16), __uint_as_float(w.x & 0xffff0000u), __uint_as_float(w.y << 16), __uint_as_float(w.y & 0xffff0000u)};
                        rv[m][bj][1] = (f32x4){__uint_as_float(w.z << 16), __uint_as_float(w.z & 0xffff0000u), __uint_as_float(w.w << 16), __uint_as_float(w.w & 0xffff0000u)}; }
            }
#pragma unroll
            for (int m = 0; m < 4; ++m) { const int row = u.pm * BM + ai * HALF + wr * 64 + m * 16 + fr; const size_t off = (size_t)row * ldc + col0; float q = 0.f;
#pragma unroll
                for (int bj = 0; bj < 2; ++bj) { const f32x4 o0 = rv[m][bj][0] + acc[ai][bj][m][0] * s, o1 = rv[m][bj][1] + acc[ai][bj][m][1] * s;
                    if (outf) { __builtin_nontemporal_store(o0, (f32x4*)(outf + off + bj * HALF)); __builtin_nontemporal_store(o1, (f32x4*)(outf + off + bj * HALF + 4)); }
                    else { q += ((o0[0] * o0[0] + o0[1] * o0[1]) + (o0[2] * o0[2] + o0[3] * o0[3])) + ((o1[0] * o1[0] + o1[1] * o1[1]) + (o1[2] * o1[2] + o1[3] * o1[3]));
                        u32x4 w; w.x = cvt_pk_bf16(o0[0], o0[1]); w.y = cvt_pk_bf16(o0[2], o0[3]); w.z = cvt_pk_bf16(o1[0], o1[1]); w.w = cvt_pk_bf16(o1[2], o1[3]); *(u32x4*)(outb + off + bj * HALF) = w; } }
                if (!outf) { q = sum_fq(q); if (fq == 0) ss[(size_t)row * 16 + 4 * u.pn + wc] = q; } }
            asm volatile("" ::: "memory");
        }
    }
};
struct EpiHead {
    static constexpr bool PERM = true, AFTER_DRAIN = false;
    bf16_t* O; bf16_t* O2; int ldc; const float* qg; const float* kg; const float* rope; int row_off; int mode; float qscale; const float* ss; const float* bf; float* logf; PG8_LAS float* sl;
    __device__ __forceinline__ void prefetch(const Unit& u, int wid, int lane) const { ss_prefetch(ss, (size_t)u.pm * BM + row_off, sl, wid, lane); }
    __device__ __forceinline__ void operator()(const f32x4 (&acc)[2][2][4][2], const Unit& u, int wr, int wc, int fr_, int fq_) const {
        int fr = fr_, fq = fq_; asm volatile("" : "+v"(fr), "+v"(fq));
        bool donorm, dorope; const float* gain; float sc = 1.f; bf16_t* base = O; int colt;
        if (mode == 0) { const int g = u.pn / 12, which = (u.pn % 12) >> 2; donorm = which < 2; dorope = donorm; gain = (which == 0 ? qg : kg) + 64 * g; if (which == 0) sc = qscale; colt = u.pn * BM; }
        else if (mode == 1) { donorm = u.pn < 4; dorope = false; gain = kg; if (u.pn >= 4) base = O2; colt = (u.pn & 3) * BM;
            if (u.pn == 8) {
                if (wc == 0 && fq < 2) {
                    const f32x4 b0 = *(const f32x4*)(bf + 8 * fq), b1 = *(const f32x4*)(bf + 8 * fq + 4);
#pragma unroll
                    for (int ai = 0; ai < 2; ++ai)
#pragma unroll
                        for (int m = 0; m < 4; ++m) { const int row = u.pm * BM + wr * 64 + fr + ai * HALF + m * 16;
                            const PG8_LAS float* sr = sl + (wr * 64 + fr + ai * HALF + m * 16) * 16;
                            const f32x4 sv0 = *(const PG8_LAS f32x4*)(sr), sv1 = *(const PG8_LAS f32x4*)(sr + 4), sv2 = *(const PG8_LAS f32x4*)(sr + 8), sv3 = *(const PG8_LAS f32x4*)(sr + 12);
                            const float tot = ((sv0[0] + sv0[1]) + (sv0[2] + sv0[3])) + ((sv1[0] + sv1[1]) + (sv1[2] + sv1[3])) + ((sv2[0] + sv2[1]) + (sv2[2] + sv2[3])) + ((sv3[0] + sv3[1]) + (sv3[2] + sv3[3]));
                            const float rs = __builtin_amdgcn_rsqf(tot * (1.0f / 1024.0f) + 1e-6f);
                            const f32x4 z0 = acc[ai][0][m][0] * rs + b0, z1 = acc[ai][0][m][1] * rs + b1; f32x4 l0, l1;
#pragma unroll
                            for (int j = 0; j < 4; ++j) { l0[j] = fminf(z0[j], 0.f) - log1pf(expf(-fabsf(z0[j]))); l1[j] = fminf(z1[j], 0.f) - log1pf(expf(-fabsf(z1[j]))); }
                            *(f32x4*)(logf + (size_t)row * 16 + 8 * fq) = l0; *(f32x4*)(logf + (size_t)row * 16 + 8 * fq + 4) = l1; }
                }
                return;
            } }
        else { donorm = true; dorope = false; gain = qg; sc = qscale; colt = u.pn * BM; }
        f32x4 gv[2][2];
#pragma unroll
        for (int bj = 0; bj < 2; ++bj)
#pragma unroll
            for (int n = 0; n < 2; ++n) gv[bj][n] = donorm ? *(const f32x4*)(gain + 32 * bj + 8 * fq + 4 * n) * sc : (f32x4){sc, sc, sc, sc};
        const int row0 = u.pm * BM + wr * 64 + fr;
        size_t rstride; bf16_t* cbase;
        if (mode == 0) { const int g = u.pn / 12, which = (u.pn % 12) >> 2, head = 4 * (u.pn & 3) + wc; const size_t bl = (size_t)(u.pm >> 4);
            rstride = 64; cbase = O + bl * (size_t)(9 * 16 * 4096 * 64) + (size_t)((g * 3 + which) * 16 + head) * (4096 * 64) + 8 * fq - bl * (size_t)(4096 * 64); }
        else { rstride = (size_t)ldc; cbase = base + colt + 64 * wc + 8 * fq; }
        float rsv[2][4]; rows_rstd_lds(rsv, sl, wr * 64 + fr, fq);
#pragma unroll
        for (int ai = 0; ai < 2; ++ai)
#pragma unroll
            for (int mp = 0; mp < 4; mp += 2) {
            f32x4 cs4[2][4];
            if (dorope) {
#pragma unroll
                for (int mm = 0; mm < 2; ++mm) { const float* cs = rope + (size_t)(row0 + ai * HALF + (mp + mm) * 16 + row_off) * 16;
#pragma unroll
                    for (int k = 0; k < 4; ++k) cs4[mm][k] = *(const f32x4*)(cs + 4 * k); } }
#pragma unroll
            for (int mm = 0; mm < 2; ++mm) { const int m = mp + mm; const int row = row0 + ai * HALF + m * 16;
                const float rs = rsv[ai][m];
                f32x4 v00 = acc[ai][0][m][0] * rs, v01 = acc[ai][0][m][1] * rs, v10 = acc[ai][1][m][0] * rs, v11 = acc[ai][1][m][1] * rs;
                if (donorm) {
                    float ss = (v00[0] * v00[0] + v00[1] * v00[1]) + (v00[2] * v00[2] + v00[3] * v00[3]);
                    ss += (v01[0] * v01[0] + v01[1] * v01[1]) + (v01[2] * v01[2] + v01[3] * v01[3]);
                    ss += (v10[0] * v10[0] + v10[1] * v10[1]) + (v10[2] * v10[2] + v10[3] * v10[3]);
                    ss += (v11[0] * v11[0] + v11[1] * v11[1]) + (v11[2] * v11[2] + v11[3] * v11[3]);
                    ss = sum_fq(ss);
                    const float rstd = __builtin_amdgcn_rsqf(ss * (1.0f / 64.0f) + 1e-6f);
                    v00 = v00 * rstd; v01 = v01 * rstd; v10 = v10 * rstd; v11 = v11 * rstd;
                }
                v00 = v00 * gv[0][0]; v01 = v01 * gv[0][1]; v10 = v10 * gv[1][0]; v11 = v11 * gv[1][1];
                if (dorope) {
                    f32x4 p0, p1;
#pragma unroll
                    for (int j = 0; j < 4; ++j) { p0[j] = xor16(v00[j], fq); p1[j] = xor16(v01[j], fq); }
                    const f32x4 c0 = cs4[mm][0], c1 = cs4[mm][1], s0 = cs4[mm][2], s1 = cs4[mm][3];
                    if (fq == 0) { v00 = v00 * c0 - p0 * s0; v01 = v01 * c1 - p1 * s1; }
                    else if (fq == 1) { v00 = v00 * c0 + p0 * s0; v01 = v01 * c1 + p1 * s1; }
                }
                bf16_t* rowp = cbase + (size_t)row * rstride;
                u32x4 w; w.x = cvt_pk_bf16(v00[0], v00[1]); w.y = cvt_pk_bf16(v00[2], v00[3]); w.z = cvt_pk_bf16(v01[0], v01[1]); w.w = cvt_pk_bf16(v01[2], v01[3]);
                *(u32x4*)rowp = w;
                w.x = cvt_pk_bf16(v10[0], v10[1]); w.y = cvt_pk_bf16(v10[2], v10[3]); w.z = cvt_pk_bf16(v11[0], v11[1]); w.w = cvt_pk_bf16(v11[2], v11[3]);
                *(u32x4*)(rowp + 32) = w; }
            asm volatile("" ::: "memory"); }
    }
};
template <class Epi, class Sched, bool ALIGN_EPI = false, bool SP2 = false>
__device__ __forceinline__ void gemm_phase(PG8_LAS unsigned char* lds, const Gemm g, const Sched& S, const Epi& E) {
    int tid_ = threadIdx.x; asm volatile("" : "+v"(tid_));
    const int tid = tid_, wid = __builtin_amdgcn_readfirstlane(tid >> 6), lane = tid & 63, wr = wid >> 2, wc = wid & 3, fr = lane & 15, fq = lane >> 4;
    const int K = g.K, nt = K / BK;
    unsigned voffA[2], voffB[2];
#pragma unroll
    for (int i = 0; i < 2; ++i) { int R, C; stage_rc(tid * 16 + i * 8192, R, C); const int Rb = Epi::PERM ? ((R & ~31) + perm32(R & 31)) : R;
        voffA[i] = (unsigned)(R * K + C) * 2u; voffB[i] = (unsigned)(Rb * K + C) * 2u; }
    const size_t kstep = (size_t)(BK * 2);
    const size_t hstep = (size_t)HALF * K * 2;
    const size_t tstep = 2 * hstep;
    const unsigned ldsw = (unsigned)wid * 1024u;
    const int aoff = lds_byte(wr * 64 + fr, fq * 8), boff = lds_byte(wc * 32 + fr, fq * 8);
#define PG8_SA(b, h) (((b) * 2 + (h)) * HTB)
#define PG8_SB(b, h) ((4 + (b) * 2 + (h)) * HTB)
#define PG8_STAGE(bufoff, gbase, voff) do { _Pragma("unroll") for (int _i = 0; _i < 2; ++_i) \
        __builtin_amdgcn_global_load_lds((const unsigned*)((const char*)(gbase) + (voff)[_i]), (PG8_LAS unsigned*)(lds + (bufoff) + ldsw + _i * 8192), 16, 0, 0); } while (0)
#define PG8_LDA(dst, b, h) do { _Pragma("unroll") for (int m = 0; m < 4; ++m) _Pragma("unroll") for (int k = 0; k < 2; ++k) dst[m][k] = *(const PG8_LAS bf16x8*)(lds + PG8_SA(b, h) + aoff + m * 2048 + k * 1024); } while (0)
#define PG8_LDB(dst, b, h) do { _Pragma("unroll") for (int n = 0; n < 2; ++n) _Pragma("unroll") for (int k = 0; k < 2; ++k) dst[n][k] = *(const PG8_LAS bf16x8*)(lds + PG8_SB(b, h) + boff + n * 2048 + k * 1024); } while (0)
#define PG8_MMA(ai, bj, At, Bt) do { __builtin_amdgcn_s_setprio(1); _Pragma("unroll") for (int m = 0; m < 4; ++m) _Pragma("unroll") for (int n = 0; n < 2; ++n) _Pragma("unroll") for (int k = 0; k < 2; ++k) \
        acc[ai][bj][m][n] = __builtin_amdgcn_mfma_f32_16x16x32_bf16(Bt[n][k], At[m][k], acc[ai][bj][m][n], 0, 0, 0); __builtin_amdgcn_s_setprio(0); } while (0)
#define PG8_WAIT_V(n) asm volatile("s_waitcnt vmcnt(" #n ")" ::: "memory")
#define PG8_WAIT_L(n) asm volatile("s_waitcnt lgkmcnt(" #n ")" ::: "memory")
#define PG8_BAR __builtin_amdgcn_s_barrier()
#define PG8_SCHED __builtin_amdgcn_sched_barrier(0)
    Unit cur, nxt; int ui = 0;
    if (!S.next(0, cur)) return;
    f32x4 acc[2][2][4][2];
#pragma unroll
    for (int a = 0; a < 2; ++a)
#pragma unroll
        for (int b = 0; b < 2; ++b)
#pragma unroll
            for (int m = 0; m < 4; ++m)
#pragma unroll
                for (int n = 0; n < 2; ++n) acc[a][b][m][n] = (f32x4){0.f, 0.f, 0.f, 0.f};
    bf16x8 At[4][2], B0[2][2], B1[2][2];
    const char* cA = (const char*)g.A + (size_t)cur.pm * tstep; const char* cB = (const char*)g.Bt + (size_t)cur.pn * tstep;
    S.a_ready(cur);
    if constexpr (SP2) {
        PG8_STAGE(PG8_SB(0, 0), cB, voffB); PG8_STAGE(PG8_SB(0, 1), cB + hstep, voffB); PG8_STAGE(PG8_SA(0, 0), cA, voffA); PG8_STAGE(PG8_SA(0, 1), cA + hstep, voffA);
        if (wr == 1) PG8_BAR;
        PG8_WAIT_V(2); PG8_BAR;
        PG8_STAGE(PG8_SB(1, 0), cB + kstep, voffB); PG8_STAGE(PG8_SA(1, 0), cA + kstep, voffA); PG8_STAGE(PG8_SB(1, 1), cB + hstep + kstep, voffB);
        PG8_WAIT_V(6); PG8_BAR;
    } else {
        PG8_STAGE(PG8_SB(0, 0), cB, voffB); PG8_STAGE(PG8_SA(0, 0), cA, voffA); PG8_STAGE(PG8_SB(0, 1), cB + hstep, voffB); PG8_STAGE(PG8_SA(0, 1), cA + hstep, voffA);
        if (wr == 1) PG8_BAR;
        PG8_WAIT_V(4); PG8_BAR;
        PG8_STAGE(PG8_SB(1, 0), cB + kstep, voffB); PG8_STAGE(PG8_SA(1, 0), cA + kstep, voffA); PG8_STAGE(PG8_SB(1, 1), cB + hstep + kstep, voffB);
        PG8_WAIT_V(6); PG8_BAR;
    }
    for (;;) {
        const bool has_next = S.next(ui + 1, nxt);
        const char* nA = has_next ? (const char*)g.A + (size_t)nxt.pm * tstep : cA; const char* nB = has_next ? (const char*)g.Bt + (size_t)nxt.pn * tstep : cB;
        for (int t = 0; t < nt; t += 2) {
            const bool last = (t == nt - 2);
            if (last) E.prefetch(cur, wid, lane);
            const char* a1 = cA + (size_t)(t + 1) * kstep;
            const char* a2 = last ? nA : cA + (size_t)(t + 2) * kstep; const char* b2 = last ? nB : cB + (size_t)(t + 2) * kstep;
            const char* a3 = a2 + kstep; const char* b3 = b2 + kstep;
            if (last && has_next) S.a_ready(nxt);
            if constexpr (SP2) {
            PG8_LDB(B0, 0, 0); PG8_LDB(B1, 0, 1); PG8_SCHED; PG8_LDA(At, 0, 0); PG8_STAGE(PG8_SA(1, 1), a1 + hstep, voffA);
            PG8_WAIT_V(8); PG8_WAIT_L(0); PG8_BAR; PG8_MMA(0, 0, At, B0); PG8_MMA(0, 1, At, B1); PG8_BAR; PG8_SCHED;
            PG8_LDA(At, 0, 1); PG8_STAGE(PG8_SB(0, 0), b2, voffB); PG8_STAGE(PG8_SB(0, 1), b2 + hstep, voffB); PG8_STAGE(PG8_SA(0, 0), a2, voffA);
            PG8_WAIT_V(8); PG8_WAIT_L(0); PG8_BAR; PG8_MMA(1, 0, At, B0); PG8_MMA(1, 1, At, B1); PG8_BAR; PG8_SCHED;
            PG8_LDB(B0, 1, 0); PG8_LDB(B1, 1, 1); PG8_SCHED; PG8_LDA(At, 1, 0); PG8_STAGE(PG8_SA(0, 1), a2 + hstep, voffA);
            PG8_WAIT_V(8); PG8_WAIT_L(0); PG8_BAR; PG8_MMA(0, 0, At, B0); PG8_MMA(0, 1, At, B1); PG8_BAR; PG8_SCHED;
            PG8_LDA(At, 1, 1); PG8_STAGE(PG8_SB(1, 0), b3, voffB); PG8_STAGE(PG8_SB(1, 1), b3 + hstep, voffB); PG8_STAGE(PG8_SA(1, 0), a3, voffA);
            PG8_WAIT_V(8); PG8_WAIT_L(0); PG8_BAR; PG8_MMA(1, 0, At, B0); PG8_MMA(1, 1, At, B1); PG8_BAR; PG8_SCHED;
            } else {
            PG8_LDB(B0, 0, 0); PG8_SCHED; PG8_LDA(At, 0, 0); PG8_STAGE(PG8_SA(1, 1), a1 + hstep, voffA);
            PG8_WAIT_L(8); PG8_BAR; PG8_WAIT_L(0); PG8_MMA(0, 0, At, B0); PG8_BAR; PG8_SCHED;
            PG8_LDB(B1, 0, 1); PG8_STAGE(PG8_SB(0, 0), b2, voffB);
            PG8_BAR; PG8_WAIT_L(0); PG8_MMA(0, 1, At, B1); PG8_BAR;
            PG8_LDA(At, 0, 1); PG8_STAGE(PG8_SA(0, 0), a2, voffA);
            PG8_BAR; PG8_WAIT_L(0); PG8_MMA(1, 0, At, B0); PG8_BAR; PG8_SCHED;
            PG8_STAGE(PG8_SB(0, 1), b2 + hstep, voffB);
            PG8_WAIT_V(6); PG8_BAR; PG8_MMA(1, 1, At, B1); PG8_BAR;
            PG8_LDB(B0, 1, 0); PG8_SCHED; PG8_LDA(At, 1, 0); PG8_STAGE(PG8_SA(0, 1), a2 + hstep, voffA);
            PG8_WAIT_L(8); PG8_BAR; PG8_WAIT_L(0); PG8_MMA(0, 0, At, B0); PG8_BAR; PG8_SCHED;
            PG8_LDB(B1, 1, 1); PG8_STAGE(PG8_SB(1, 0), b3, voffB);
            PG8_BAR; PG8_WAIT_L(0); PG8_MMA(0, 1, At, B1); PG8_BAR;
            PG8_LDA(At, 1, 1); PG8_STAGE(PG8_SA(1, 0), a3, voffA);
            PG8_BAR; PG8_WAIT_L(0); PG8_MMA(1, 0, At, B0); PG8_BAR; PG8_SCHED;
            PG8_STAGE(PG8_SB(1, 1), b3 + hstep, voffB);
            PG8_WAIT_V(6); PG8_BAR; PG8_MMA(1, 1, At, B1); PG8_BAR;
            }
        }
        if constexpr (ALIGN_EPI) { if (wr == 0) PG8_BAR; }
        if constexpr (!Epi::AFTER_DRAIN) { E(acc, cur, wr, wc, fr, fq); S.done(cur); }
        if (!has_next) break;
#pragma unroll
        for (int a = 0; a < 2; ++a)
#pragma unroll
            for (int b = 0; b < 2; ++b)
#pragma unroll
                for (int m = 0; m < 4; ++m)
#pragma unroll
                    for (int n = 0; n < 2; ++n) acc[a][b][m][n] = (f32x4){0.f, 0.f, 0.f, 0.f};
        cur = nxt; cA = nA; cB = nB; ++ui;
        if constexpr (ALIGN_EPI) { if (wr == 1) PG8_BAR; }
    }
    PG8_WAIT_V(0);
    if constexpr (!ALIGN_EPI) { if (wr == 0) PG8_BAR; }
    PG8_BAR;
    if constexpr (Epi::AFTER_DRAIN) { E.fused(acc, cur, wr, wc, fr, fq, lds, wid, lane); S.done(cur); }
#undef PG8_SA
#undef PG8_SB
#undef PG8_STAGE
#undef PG8_LDA
#undef PG8_LDB
#undef PG8_MMA
#undef PG8_WAIT_V
#undef PG8_WAIT_L
#undef PG8_BAR
#undef PG8_SCHED
}
}
#include <hip/hip_bf16.h>
#include <cmath>
namespace attn_body {
using bf16=__hip_bfloat16;
using bf16x8=__attribute__((ext_vector_type(8)))short;
using s16x4=__attribute__((ext_vector_type(4)))short;
using f32x16=__attribute__((ext_vector_type(16)))float;
using u32x4=__attribute__((ext_vector_type(4)))unsigned;
constexpr int D=64;
constexpr int NW=8,QBLK=32,QB=QBLK*NW,KVBLK=64;
#define ALAS __attribute__((address_space(3)))
typedef float af32x4 __attribute__((ext_vector_type(4)));
__device__ __forceinline__ int crow(int r,int hi){return (r&3)+8*(r>>2)+4*hi;}
#define SBAR() __builtin_amdgcn_sched_barrier(0)
template<int MODE> __device__ __forceinline__ void bmask(f32x16&p0,f32x16&p1,int t,int qo,int hi){
  const float NEG=-INFINITY; const int kb=64*t+4*hi;
  #pragma unroll
  for(int r=0;r<16;++r){const int kv=kb+(r&3)+8*(r>>2);
    if(MODE==0){ if(kv>qo)p0[r]=NEG; if(kv+32>qo)p1[r]=NEG; }
    else { if(kv>qo||kv<qo-128)p0[r]=NEG; if(kv+32>qo||kv+32<qo-128)p1[r]=NEG; } }
}

template<int MODE> __device__ __forceinline__ void bmask2(f32x16&p0,f32x16&p1,int t,int qo,int qolo,int hi){
  const float NEG=-INFINITY; const int kb=64*t+4*hi;
  if(64*t+63>qolo){
    #pragma unroll
    for(int r=0;r<16;++r){const int kv=kb+(r&3)+8*(r>>2); if(kv>qo)p0[r]=NEG; if(kv+32>qo)p1[r]=NEG; } }
  if(MODE==1&&64*t<qolo-97){
    #pragma unroll
    for(int r=0;r<16;++r){const int kv=kb+(r&3)+8*(r>>2); if(kv<qo-128)p0[r]=NEG; if(kv+32<qo-128)p1[r]=NEG; } }
}

constexpr int NSLOT=3, SLOTB=8192;
constexpr int LDS_K=0, LDS_V=NSLOT*SLOTB, LDS_WS=2*NSLOT*SLOTB, LDS_OST=LDS_WS+NW*64*4, LDS_BYTES=LDS_OST+NW*4096;
constexpr float C2=0.125f*1.4426950408889634f;
__device__ __forceinline__ void glds16(const void*gsrc,unsigned lds_dst){unsigned keep;
  asm volatile("s_mov_b32 %0, m0\n\ts_mov_b32 m0, %2\n\ts_nop 0\n\tglobal_load_lds_dwordx4 %1, off\n\ts_mov_b32 m0, %0":"=&s"(keep):"v"(gsrc),"s"(lds_dst):"memory");}
__device__ __forceinline__ float max3f(float a,float b,float c){float r;asm("v_max3_f32 %0, %1, %2, %3":"=v"(r):"v"(a),"v"(b),"v"(c));return r;}
__device__ __forceinline__ float max2f(float a,float b){float r;asm("v_max_f32_e32 %0, %1, %2":"=v"(r):"v"(a),"v"(b));return r;}
__device__ __forceinline__ float fadd_s(float a,float b){float r;asm("v_add_f32_e32 %0, %1, %2":"=v"(r):"v"(a),"v"(b));return r;}
__device__ __forceinline__ float fsub_s(float a,float b){float r;asm("v_sub_f32_e32 %0, %1, %2":"=v"(r):"v"(a),"v"(b));return r;}
typedef float f32x2_t __attribute__((ext_vector_type(2))); typedef __bf16 bf16x2_t __attribute__((ext_vector_type(2)));
__device__ __forceinline__ unsigned cvtpk_s(float lo,float hi){f32x2_t v={lo,hi};bf16x2_t b=__builtin_convertvector(v,bf16x2_t);return __builtin_bit_cast(unsigned,b);}
#define WAIT_BAR(N) asm volatile("s_waitcnt vmcnt(" #N ") lgkmcnt(0)\n\ts_barrier":::"memory")

__device__ __forceinline__ void qkt(f32x16&p0,f32x16&p1,const char*Kslot,const bf16x8*qr,int r32,int hi){
  const char*kb=Kslot+hi*1024+r32*16;
  #pragma unroll
  for(int d0=0;d0<4;++d0){
    const bf16x8 b0=*reinterpret_cast<const bf16x8*>(kb+d0*2048);
    const bf16x8 b1=*reinterpret_cast<const bf16x8*>(kb+d0*2048+512);
    {p0=__builtin_amdgcn_mfma_f32_32x32x16_bf16(b0,qr[d0],p0,0,0,0);p1=__builtin_amdgcn_mfma_f32_32x32x16_bf16(b1,qr[d0],p1,0,0,0);}}
}
typedef __attribute__((address_space(3))) const char* lds_cptr;
typedef short v4i16_t __attribute__((ext_vector_type(4)));
__device__ __forceinline__ void kload8(bf16x8*kf,lds_cptr kp){
  kf[0]=*(const __attribute__((address_space(3))) bf16x8*)(kp);      kf[1]=*(const __attribute__((address_space(3))) bf16x8*)(kp+512);
  kf[2]=*(const __attribute__((address_space(3))) bf16x8*)(kp+2048); kf[3]=*(const __attribute__((address_space(3))) bf16x8*)(kp+2560);
  kf[4]=*(const __attribute__((address_space(3))) bf16x8*)(kp+4096); kf[5]=*(const __attribute__((address_space(3))) bf16x8*)(kp+4608);
  kf[6]=*(const __attribute__((address_space(3))) bf16x8*)(kp+6144); kf[7]=*(const __attribute__((address_space(3))) bf16x8*)(kp+6656);
}
__device__ __forceinline__ void kload2(bf16x8*kf,lds_cptr kp,int j){ kf[2*j]=*(const __attribute__((address_space(3))) bf16x8*)(kp+j*2048); kf[2*j+1]=*(const __attribute__((address_space(3))) bf16x8*)(kp+j*2048+512); }
__device__ __forceinline__ s16x4 vtr(lds_cptr p){ return __builtin_bit_cast(s16x4,__builtin_amdgcn_ds_read_tr16_b64_v4i16((__attribute__((address_space(3))) v4i16_t*)p)); }
__device__ __forceinline__ float rowmax(const f32x16&p0,const f32x16&p1){
  float a=max3f(p0[0],p0[1],p1[0]),b=max3f(p0[2],p0[3],p1[1]);a=max3f(a,p1[2],p1[3]);
  #pragma unroll
  for(int r=4;r<16;r+=4){a=max3f(a,p0[r],p0[r+1]);b=max3f(b,p0[r+2],p0[r+3]);a=max3f(a,p1[r],p1[r+1]);b=max3f(b,p1[r+2],p1[r+3]);}
  const float m=max2f(a,b);
  auto rr=__builtin_amdgcn_permlane32_swap(__float_as_uint(m),__float_as_uint(m),false,false);
  return max2f(__uint_as_float(rr[0]),__uint_as_float(rr[1]));
}
__device__ __forceinline__ void pv(f32x16*o,int vb,bf16x8 pa0,bf16x8 pa1,bf16x8 pa2,bf16x8 pa3){
  #pragma unroll
  for(int d0=0;d0<2;++d0){s16x4 lo[4],hi[4];
    #pragma unroll
    for(int ks=0;ks<4;++ks){
      asm volatile("ds_read_b64_tr_b16 %0,%1 offset:%c2":"=&v"(lo[ks]):"v"(vb),"i"(d0*4096+ks*1024):"memory");
      asm volatile("ds_read_b64_tr_b16 %0,%1 offset:%c2":"=&v"(hi[ks]):"v"(vb),"i"(d0*4096+ks*1024+512):"memory");}
    asm volatile("s_waitcnt lgkmcnt(0)":::"memory");SBAR();
    #define PK(k) (bf16x8){lo[k][0],lo[k][1],lo[k][2],lo[k][3],hi[k][0],hi[k][1],hi[k][2],hi[k][3]}
    o[d0]=__builtin_amdgcn_mfma_f32_32x32x16_bf16(pa0,PK(0),o[d0],0,0,0);
    o[d0]=__builtin_amdgcn_mfma_f32_32x32x16_bf16(pa1,PK(1),o[d0],0,0,0);
    o[d0]=__builtin_amdgcn_mfma_f32_32x32x16_bf16(pa2,PK(2),o[d0],0,0,0);
    o[d0]=__builtin_amdgcn_mfma_f32_32x32x16_bf16(pa3,PK(3),o[d0],0,0,0);
    #undef PK
  }
}

#ifndef ATTN_STORE16
#define ATTN_STORE16(p,v) (*(u32x4*)(p)=(v))
#endif
#define QIMG_OFF(w) ((w)<7?100352+4096*(w):131328)
template<int MODE,int THRL,bool COMB=false,bool NOMAX=false> __device__ __forceinline__ void attn_unit(const bf16*Qp,const bf16*Kp,const bf16*Vp,bf16*Op,long P,int NT,int qoff,const ALAS float*cumL,float*lsep,long lse_stride,char*shm,bool pre,const bf16*Qn,const bf16*Kn,long Pn,bf16*mixp=nullptr,long mix_stride=0,long lse_gstride=0,long o_gstride=0){
  int tid_=threadIdx.x; asm volatile("":"+v"(tid_)); const int tid=tid_,lane=tid&63,r32=lane&31,hi=lane>>5; const int wid=__builtin_amdgcn_readfirstlane(tid>>6);
  const bf16*Qw=Qp+(long)(wid*QBLK)*P;
  const bf16*Kh=Kp,*Vh=Vp;
  const unsigned lds0=(unsigned)(uintptr_t)shm;
  float*wsf=(float*)(shm+LDS_WS)+wid*64;
  const bf16*ksrc=Kh+(long)lane*P+wid*8;
  const bf16*vsrc=Vh+(long)(16*(wid&3)+(lane>>2))*P+(wid>>2)*32+(lane&3)*8;
  const unsigned kdst=lds0+LDS_K+wid*1024, vdst=lds0+LDS_V+wid*1024;
  #define DMA_K(t,slot) glds16(ksrc+(long)(t)*KVBLK*P,(unsigned)__builtin_amdgcn_readfirstlane(kdst+(slot)))
  #define DMA_V(t,slot) glds16(vsrc+(long)(t)*KVBLK*P,(unsigned)__builtin_amdgcn_readfirstlane(vdst+(slot)))
  const int vb0=(int)(lds0+LDS_V)+((lane>>4)&1)*32+(lane&3)*8+(4*hi+((lane&15)>>2))*64;
  const char*Kbase=shm+LDS_K; bf16x8 kf[8];
  const lds_cptr shm3=(lds_cptr)shm; const lds_cptr kp0=shm3+LDS_K+hi*1024+r32*16; const lds_cptr vp0=shm3+LDS_V+((lane>>4)&1)*32+(lane&3)*8+(4*hi+((lane&15)>>2))*64;
  if(!pre){DMA_K(0,0);
    { const bf16*q0_=Qp+(long)(wid*QBLK+(lane>>3))*P+(lane&7)*8;
      _Pragma("unroll") for(int pc_=0;pc_<4;++pc_)glds16(q0_+(long)(8*pc_)*P,(unsigned)__builtin_amdgcn_readfirstlane(lds0+QIMG_OFF(wid)+1024*pc_)); }
    DMA_V(0,0);DMA_K(1,SLOTB);}else{DMA_V(0,0);}
  bf16x8 qr[4];
  float mhat=0.f,l_reg=0.f;f32x16 o[2];o[0]=f32x16{};o[1]=f32x16{};
  const int qrel=wid*QBLK+r32, qo=qrel+qoff;
  const int qolo=wid*QBLK+qoff; const int t_lo=(MODE==1)?(((qolo-128)>0?(qolo-128):0)>>6):0; const int t_hi=(qolo+31)>>6;
  const float cq2=(MODE==0)?cumL[qo]:0.f; float qb=cq2;
  #define CMASK(P0,P1,t) do{ if(MODE==1||(t)>=NT-4)bmask2<MODE>(P0,P1,(t),qo,qolo,hi); }while(0)
  #define BIASFILL(C0,C1,t) do{ if(MODE==0){ const ALAS float*cp_=cumL+64*(t)+4*hi; \
      _Pragma("unroll") for(int g_=0;g_<4;++g_){ const af32x4 a_=*(const ALAS af32x4*)(cp_+8*g_), b_=*(const ALAS af32x4*)(cp_+32+8*g_); \
        C0[4*g_]=qb-a_.x;C0[4*g_+1]=qb-a_.y;C0[4*g_+2]=qb-a_.z;C0[4*g_+3]=qb-a_.w; C1[4*g_]=qb-b_.x;C1[4*g_+1]=qb-b_.y;C1[4*g_+2]=qb-b_.z;C1[4*g_+3]=qb-b_.w; } } \
    else if(!NOMAX){ _Pragma("unroll") for(int r_=0;r_<16;++r_){C0[r_]=qb;C1[r_]=qb;} } }while(0)
  #define CIN(C) ((NOMAX&&MODE==1)?f32x16{}:(C))
  bool resc=false;
  #define START(P0,P1) do{ resc=false; if(!NOMAX){ const float rm=rowmax(P0,P1); \
    { const float dl=__builtin_fmaxf(rm,-64.f); mhat=fadd_s(mhat,dl); qb=cq2-mhat; \
      _Pragma("unroll") for(int r=0;r<16;++r){P0[r]=fsub_s(P0[r],dl);P1[r]=fsub_s(P1[r],dl);} \
      } } \
    _Pragma("unroll") for(int r=0;r<16;++r)P0[r]=__builtin_amdgcn_exp2f(P0[r]); }while(0)
  #define RESC() do{ if(resc){ asm volatile("s_waitcnt lgkmcnt(0)":::"memory"); \
      _Pragma("unroll") for(int d_=0;d_<2;++d_) _Pragma("unroll") for(int r=0;r<16;++r)o[d_][r]*=wsf[crow(r,hi)]; } }while(0)
  f32x16 pA0,pA1,pB0,pB1;
  int sl_prev=0,sl_cur=0,sl_next=SLOTB;
  #define ROT() do{sl_prev=sl_cur;sl_cur=sl_next;sl_next=(sl_next==(NSLOT-1)*SLOTB)?0:sl_next+SLOTB;}while(0)
  if(!pre){DMA_K(2,2*SLOTB);
    WAIT_BAR(3);}
  else{WAIT_BAR(1);}
  {
    const ALAS char*qimg_=(const ALAS char*)(shm3+QIMG_OFF(wid))+r32*128+hi*16;
    _Pragma("unroll") for(int d0=0;d0<4;++d0)qr[d0]=*(const ALAS bf16x8*)(qimg_+d0*32); }
  asm volatile("s_waitcnt lgkmcnt(0)":::"memory");
  if(0)WAIT_BAR(3);
  if(MODE==1&&t_lo>0){ pA0=f32x16{}; pA1=f32x16{}; resc=false; }
  else{
  BIASFILL(pA0,pA1,0); if(NOMAX&&MODE==1){pA0=f32x16{};pA1=f32x16{};} qkt(pA0,pA1,Kbase,qr,r32,hi);asm volatile("s_nop 15\n\ts_nop 7":"+v"(pA0),"+v"(pA1));CMASK(pA0,pA1,0);
  START(pA0,pA1);
  _Pragma("unroll") for(int r=0;r<16;++r)pA1[r]=__builtin_amdgcn_exp2f(pA1[r]);
  }
  WAIT_BAR(0);
  DMA_K(3,0);DMA_V(1,SLOTB);
  ROT();
  kload8(kf,kp0+sl_cur);
  WAIT_BAR(2);
  s16x4 vlo[8],vhi[8]; u32x4 pw0,pw1,pw2,pw3;
  #define PKW(P,B) cvtpk_s(P[B],P[B+1])
  #define PAF(k) __builtin_bit_cast(bf16x8,pw##k)
  #define VFR(i) (bf16x8){vlo[i][0],vlo[i][1],vlo[i][2],vlo[i][3],vhi[i][0],vhi[i][1],vhi[i][2],vhi[i][3]}
  #define PIN(x) asm volatile("":"+v"(x))
  #define MX3(a,b,c) __builtin_fmaxf(__builtin_fmaxf((a),(b)),(c))
  #define GAPA(MF,A0,A1,A2,A3,W0,W1,PW) do{ MF; sacc+=A0; sacc+=A1; sacc+=A2; sacc+=A3; PIN(sacc); W0; W1; PIN(PW); SBAR(); }while(0)
  #define EX(v) __builtin_amdgcn_exp2f(v)
  #define GAPB(MF,X,B) do{ MF; X[B]=EX(X[B]); X[B+1]=EX(X[B+1]); X[B+2]=EX(X[B+2]); X[B+3]=EX(X[B+3]); PIN(X); SBAR(); }while(0)
  #define VRD(i) do{ vlo[i]=vtr(vp_+(((i)>>2)*4096+((i)&3)*1024)); vhi[i]=vtr(vp_+(((i)>>2)*4096+((i)&3)*1024+512)); }while(0)
  #define KRD(G,j) do{ if(G){ kload2(kf,kp0+sl_next,j); SBAR(); } }while(0)
  #define STEP(C0,C1,P0,P1,t,GK,GV,GL) do{ SBAR(); BIASFILL(C0,C1,t); SBAR(); \
    const lds_cptr vp_=vp0+sl_prev; \
    VRD(0); SBAR(); float sacc=(P0[0]+P0[1]); \
    GAPA(C0=__builtin_amdgcn_mfma_f32_32x32x16_bf16(kf[0],qr[0],CIN(C0),0,0,0), P0[2],P0[3],P0[4],P0[5],     pw0[0]=PKW(P0,0), pw0[1]=PKW(P0,2), pw0); \
    VRD(4); SBAR(); GAPA(C1=__builtin_amdgcn_mfma_f32_32x32x16_bf16(kf[1],qr[0],CIN(C1),0,0,0), P0[6],P0[7],P0[8],P0[9],     pw0[2]=PKW(P0,4), pw0[3]=PKW(P0,6), pw0); \
    VRD(1); SBAR(); GAPA(C0=__builtin_amdgcn_mfma_f32_32x32x16_bf16(kf[2],qr[1],C0,0,0,0),   P0[10],P0[11],P0[12],P0[13], pw1[0]=PKW(P0,8), pw1[1]=PKW(P0,10), pw1); \
    VRD(5); SBAR(); GAPA(C1=__builtin_amdgcn_mfma_f32_32x32x16_bf16(kf[3],qr[1],C1,0,0,0),   P0[14],P0[15],P1[0],P1[1],   pw1[2]=PKW(P0,12),pw1[3]=PKW(P0,14), pw1); \
    VRD(2); SBAR(); GAPA(C0=__builtin_amdgcn_mfma_f32_32x32x16_bf16(kf[4],qr[2],C0,0,0,0),   P1[2],P1[3],P1[4],P1[5],     pw2[0]=PKW(P1,0), pw2[1]=PKW(P1,2), pw2); \
    VRD(6); SBAR(); GAPA(C1=__builtin_amdgcn_mfma_f32_32x32x16_bf16(kf[5],qr[2],C1,0,0,0),   P1[6],P1[7],P1[8],P1[9],     pw2[2]=PKW(P1,4), pw2[3]=PKW(P1,6), pw2); \
    VRD(3); SBAR(); GAPA(C0=__builtin_amdgcn_mfma_f32_32x32x16_bf16(kf[6],qr[3],C0,0,0,0),   P1[10],P1[11],P1[12],P1[13], pw3[0]=PKW(P1,8), pw3[1]=PKW(P1,10), pw3); \
    VRD(7); SBAR(); GAPA(C1=__builtin_amdgcn_mfma_f32_32x32x16_bf16(kf[7],qr[3],C1,0,0,0),   P1[14],P1[15],0.f,0.f,       pw3[2]=PKW(P1,12),pw3[3]=PKW(P1,14), pw3); \
    l_reg+=sacc; \
    if(GK){DMA_K((t)+3,sl_cur);} if(GV){DMA_V((t)+1,sl_next);} \
    CMASK(C0,C1,t); resc=false; \
    if(!NOMAX){ float a=MX3(C0[0],C0[1],C1[0]),b=MX3(C0[2],C0[3],C1[1]); a=MX3(a,C1[2],C1[3]); \
      _Pragma("unroll") for(int r=4;r<16;r+=4){a=MX3(a,C0[r],C0[r+1]);b=MX3(b,C0[r+2],C0[r+3]);a=MX3(a,C1[r],C1[r+1]);b=MX3(b,C1[r+2],C1[r+3]);} \
      float rm=__builtin_fmaxf(a,b); { auto rr=__builtin_amdgcn_permlane32_swap(__float_as_uint(rm),__float_as_uint(rm),false,false); rm=__builtin_fmaxf(__uint_as_float(rr[0]),__uint_as_float(rr[1])); } \
      resc=false; \
      if(__builtin_expect(__any(rm>(float)THRL),0)){ const float dl=__builtin_fmaxf(rm,0.f); mhat+=dl; \
        _Pragma("unroll") for(int r=0;r<16;++r){C0[r]-=dl;C1[r]-=dl;} \
        qb=cq2-mhat; \
        const float f=__builtin_amdgcn_exp2f(-dl); l_reg*=f; if(hi==0)wsf[r32]=f; resc=true; } } \
    SBAR(); \
    GAPB(o[0]=__builtin_amdgcn_mfma_f32_32x32x16_bf16(PAF(0),VFR(0),o[0],0,0,0), C0,0); \
    GAPB(o[1]=__builtin_amdgcn_mfma_f32_32x32x16_bf16(PAF(0),VFR(4),o[1],0,0,0), C0,4); \
    KRD(GL,0); GAPB(o[0]=__builtin_amdgcn_mfma_f32_32x32x16_bf16(PAF(1),VFR(1),o[0],0,0,0), C0,8); \
    KRD(GL,1); GAPB(o[1]=__builtin_amdgcn_mfma_f32_32x32x16_bf16(PAF(1),VFR(5),o[1],0,0,0), C0,12); \
    KRD(GL,2); GAPB(o[0]=__builtin_amdgcn_mfma_f32_32x32x16_bf16(PAF(2),VFR(2),o[0],0,0,0), C1,0); \
    KRD(GL,3); GAPB(o[1]=__builtin_amdgcn_mfma_f32_32x32x16_bf16(PAF(2),VFR(6),o[1],0,0,0), C1,4); \
    GAPB(o[0]=__builtin_amdgcn_mfma_f32_32x32x16_bf16(PAF(3),VFR(3),o[0],0,0,0), C1,8); \
    GAPB(o[1]=__builtin_amdgcn_mfma_f32_32x32x16_bf16(PAF(3),VFR(7),o[1],0,0,0), C1,12); \
    }while(0)
  #define XSTEP(C0,C1,P0,P1,t,GK,GV,GL) do{ const int t_=(t); if(t_>=t_lo&&t_<=t_hi+1){ STEP(C0,C1,P0,P1,t,GK,GV,GL); } \
    else{ if(GK){DMA_K(t_+3,sl_cur);} if(GV){DMA_V(t_+1,sl_next);} if(GL){kload8(kf,kp0+sl_next);} \
      _Pragma("unroll") for(int r_=0;r_<16;++r_){C0[r_]=0.f;C1[r_]=0.f;} resc=false; } }while(0)
  int t=1;
  #undef CMASK
  #define CMASK(P0,P1,t) do{}while(0)
  for(;t+5<NT;t+=2){
    STEP(pB0,pB1,pA0,pA1,t,true,true,true);     WAIT_BAR(2); RESC(); ROT();
    STEP(pA0,pA1,pB0,pB1,t+1,true,true,true);   WAIT_BAR(2); RESC(); ROT();
  }
  #undef CMASK
  #define CMASK(P0,P1,t) do{ if(MODE==1||(t)>=NT-4)bmask2<MODE>(P0,P1,(t),qo,qolo,hi); }while(0)
  #define ENDW(tt) do{ if((tt)+3<NT){WAIT_BAR(2);} else if((tt)+2<NT){WAIT_BAR(1);} else {WAIT_BAR(0);} }while(0)
  for(;t+1<NT;t+=2){
    STEP(pB0,pB1,pA0,pA1,t,(t+3<NT),(t+1<NT),(t+1<NT));       ENDW(t);   RESC(); ROT();
    STEP(pA0,pA1,pB0,pB1,t+1,(t+4<NT),(t+2<NT),(t+2<NT));     ENDW(t+1); RESC(); ROT();
  }
  if(Kn){ const bf16*kn_=Kn+(long)lane*Pn+wid*8;
    glds16(kn_,(unsigned)__builtin_amdgcn_readfirstlane(kdst)); glds16(kn_+(long)KVBLK*Pn,(unsigned)__builtin_amdgcn_readfirstlane(kdst+SLOTB)); glds16(kn_+(long)2*KVBLK*Pn,(unsigned)__builtin_amdgcn_readfirstlane(kdst+2*SLOTB));
    const bf16*qn_=Qn+(long)(wid*QBLK+(lane>>3))*Pn+(lane&7)*8;
    _Pragma("unroll") for(int pc_=0;pc_<4;++pc_)glds16(qn_+(long)(8*pc_)*Pn,(unsigned)__builtin_amdgcn_readfirstlane(lds0+QIMG_OFF(wid)+1024*pc_)); }
  STEP(pB0,pB1,pA0,pA1,NT-1,false,false,false); RESC();
  { float sacc=pB0[0]+pB0[1]; _Pragma("unroll") for(int r=2;r<16;++r)sacc+=pB0[r]; _Pragma("unroll") for(int r=0;r<16;++r)sacc+=pB1[r]; l_reg+=sacc;
    pw0=(u32x4){PKW(pB0,0),PKW(pB0,2),PKW(pB0,4),PKW(pB0,6)};pw1=(u32x4){PKW(pB0,8),PKW(pB0,10),PKW(pB0,12),PKW(pB0,14)};pw2=(u32x4){PKW(pB1,0),PKW(pB1,2),PKW(pB1,4),PKW(pB1,6)};pw3=(u32x4){PKW(pB1,8),PKW(pB1,10),PKW(pB1,12),PKW(pB1,14)};
    SBAR(); pv(o,vb0+sl_cur,PAF(0),PAF(1),PAF(2),PAF(3)); }
  SBAR();
  SBAR();
  #undef PKW
  #undef PAF
  #undef VFR
  #undef PIN
  #undef MX3
  #undef GAPA
  #undef GAPB
  #undef EX
  #undef VRD
  #undef KRD
  #undef STEP
  #undef XSTEP
  #undef ENDW
  {auto rr=__builtin_amdgcn_permlane32_swap(__float_as_uint(l_reg),__float_as_uint(l_reg),false,false);l_reg=__uint_as_float(rr[0])+__uint_as_float(rr[1]);}
  const float lse2_=mhat+__builtin_amdgcn_logf(l_reg);
  if(MODE==1&&!COMB&&hi==0)lsep[(long)qrel*lse_stride]=lse2_;
  if(COMB&&hi==0)wsf[r32]=lse2_;
  if(hi==0)wsf[32+r32]=l_reg;asm volatile("s_waitcnt lgkmcnt(0)":::"memory");
  float rli[16];
  #pragma unroll
  for(int r=0;r<16;++r)rli[r]=__builtin_amdgcn_rcpf(wsf[32+crow(r,hi)]);
  bf16*Ow=Op+(long)(wid*QBLK)*P;
  { bf16*stg=(bf16*)(shm+LDS_OST)+wid*2048;
    #pragma unroll
    for(int r=0;r<16;++r){const int orow=crow(r,hi);
      #pragma unroll
      for(int d0=0;d0<2;++d0)stg[orow*64+d0*32+r32]=__float2bfloat16(o[d0][r]*rli[r]);}
    asm volatile("s_waitcnt lgkmcnt(0)":::"memory");
    if(!COMB){
      #pragma unroll
      for(int i=0;i<4;++i){const int row=i*8+(lane>>3),ch=lane&7; const u32x4 v=*(const u32x4*)(stg+row*64+ch*8); ATTN_STORE16(Ow+(long)row*P+ch*8,v);} }
    else{
      const int ch=lane&7; u32x4 a0[4],a1[4]; float l0[4],l1[4];
      #pragma unroll
      for(int i=0;i<4;++i){const int row=i*8+(lane>>3); const bf16*o0p=Ow-2*o_gstride+(long)row*P+ch*8; a0[i]=*(const u32x4*)o0p; a1[i]=*(const u32x4*)(o0p+o_gstride);
        const long lr=(long)(wid*QBLK+row)*lse_stride; l0[i]=lsep[lr-2*lse_gstride]; l1[i]=lsep[lr-lse_gstride]; }
      #pragma unroll
      for(int i=0;i<4;++i){const int row=i*8+(lane>>3); const u32x4 v=*(const u32x4*)(stg+row*64+ch*8); const float l2=wsf[row];
        const float mx=__builtin_fmaxf(l0[i],__builtin_fmaxf(l1[i],l2)); float w0=__builtin_amdgcn_exp2f(l0[i]-mx), w1=__builtin_amdgcn_exp2f(l1[i]-mx), w2=__builtin_amdgcn_exp2f(l2-mx);
        const float inv=__builtin_amdgcn_rcpf(w0+w1+w2); w0*=inv; w1*=inv; w2*=inv; u32x4 y;
        #pragma unroll
        for(int k=0;k<4;++k){ const float lo=w0*__uint_as_float(a0[i][k]<<16)+w1*__uint_as_float(a1[i][k]<<16)+w2*__uint_as_float(v[k]<<16);
          const float hh=w0*__uint_as_float(a0[i][k]&0xffff0000u)+w1*__uint_as_float(a1[i][k]&0xffff0000u)+w2*__uint_as_float(v[k]&0xffff0000u); y[k]=cvtpk_s(lo,hh); }
        *(u32x4*)(mixp+(long)(wid*QBLK+row)*mix_stride+ch*8)=y; } } }
  asm volatile("s_waitcnt lgkmcnt(0)\n\ts_barrier":::"memory");
  #undef DMA_K
  #undef DMA_V
  #undef CMASK
  #undef START
  #undef RESC
  #undef ROT
  #undef BIASFILL
  #undef CIN
}
constexpr int ATTN_LDS_BYTES=LDS_BYTES;
#undef SBAR
#undef WAIT_BAR
}
#define LAS __attribute__((address_space(3)))
typedef unsigned short bf16;
typedef float f32x4 __attribute__((ext_vector_type(4)));
typedef short bf16x8 __attribute__((ext_vector_type(8)));
typedef unsigned v4u __attribute__((ext_vector_type(4)));
typedef unsigned v2u __attribute__((ext_vector_type(2)));

constexpr int DM = 1024, NB = 16, SEQ = 4096, M = NB * SEQ, FF = 2816, FF2 = 2 * FF, NH = 16, NQKV = 9216, HALF_M = M / 2;
constexpr float EPS = 1e-6f, LOG2E = 1.4426950408889634f, C2 = 0.125f * 1.4426950408889634f;
constexpr int NWAVES = 8, NTHREADS = 512, LDS_BYTES = 148480, LDS_SS_OFF = 131072 + 256;
constexpr size_t MiB = 1u << 20;
constexpr size_t WS_WIN = 2 * MiB, WIN_SZ = (size_t)FF2 * DM * 2;
constexpr size_t WS_WOUT = WS_WIN + 4 * WIN_SZ, WOUT_SZ = (size_t)DM * FF * 2;
constexpr size_t WS_WQKV = WS_WOUT + 4 * WOUT_SZ;
constexpr size_t WS_WAO = WS_WQKV + (size_t)NQKV * DM * 2, WS_WKV = WS_WAO + 2 * MiB, WS_WBQ = WS_WKV + 5 * MiB, WS_WBO = WS_WBQ + 2 * MiB, WS_WEND = WS_WBO + 2 * MiB;
static_assert(WS_WEND <= 98 * MiB, "weights");
constexpr size_t WS_BAR = 0, CTL_ZERO_BYTES = 16384;
constexpr size_t WS_ROPE = 98 * MiB, WS_LOGF = 102 * MiB, WS_CUM = 106 * MiB, WS_LSE = 110 * MiB, WS_SS = 116 * MiB;
constexpr size_t WS_XN = 128 * MiB, WS_MIX = 256 * MiB, WS_BIG = 384 * MiB;
constexpr size_t WS_ACT = WS_BIG, WS_QKV = WS_BIG, WS_XN2 = 736 * MiB, WS_QB = 736 * MiB, WS_KB = 256 * MiB, WS_VB = 864 * MiB, WS_END = 992 * MiB;
static_assert(WS_ACT + (size_t)M * FF * 2 <= WS_XN2 && WS_QKV + (size_t)HALF_M * NQKV * 2 <= WS_END, "map");

struct Params {
    const float* x; const int* pos; const float* ffn_norm; const float* ffn_w_in; const float* ffn_w_out; const float* mix_norm;
    const float* a_w_qkv; const float* a_q_norm; const float* a_k_norm; const float* a_w_o; const float* kv_norm; const float* kv_w;
    const float* kv_b_f; const float* kv_k_norm; const float* b_w_q; const float* b_q_norm; const float* b_w_o;
    float* out; unsigned char* ws;
    float invf[8];
};

__device__ __forceinline__ unsigned f2bf(float f) { unsigned u = __builtin_bit_cast(unsigned, f); return (u + 0x7fffu + ((u >> 16) & 1u)) >> 16; }
__device__ __forceinline__ unsigned pk2(float lo, float hi) { return f2bf(lo) | (f2bf(hi) << 16); }
__device__ __forceinline__ float bf2f(short h) { return __uint_as_float(((unsigned)(unsigned short)h) << 16); }
__device__ __forceinline__ float wave_sum(float v) {
#pragma unroll
    for (int o = 1; o < 64; o <<= 1) v += __shfl_xor(v, o);
    return v;
}
#define LDS_WAIT() asm volatile("s_waitcnt lgkmcnt(0)" ::: "memory")

#define XB_TMO      128
#define XB_XCNT(j)  (256  + 64 * (j))
#define XB_XSUB(j)  (1280 + 64 * (j))
#define XB_XGEN(j)  (2304 + 64 * (j))
#define XB_TOP      3328
#define XB_TOPGEN   3392
#define XCD_BAR_WORDS 3456
#define XB_SPIN_CAP (1u << 18)

__device__ __forceinline__ unsigned xb_ld(unsigned* p)              { return __hip_atomic_load(p, __ATOMIC_RELAXED, __HIP_MEMORY_SCOPE_AGENT); }
__device__ __forceinline__ unsigned xb_add(unsigned* p, unsigned v) { return __hip_atomic_fetch_add(p, v, __ATOMIC_RELAXED, __HIP_MEMORY_SCOPE_AGENT); }
__device__ __forceinline__ unsigned xb_xcc_id() { return (unsigned)__builtin_amdgcn_s_getreg((3 << 11) | 20) & 0xFu; }
#define XB_SPIN(cond, bar) do { unsigned _sp = 0; while (cond) { __builtin_amdgcn_s_sleep(1); \
    if ((++_sp & 255u) == 0u) { if (xb_ld(&(bar)[XB_TMO])) break; if (_sp > XB_SPIN_CAP) { atomicAdd(&(bar)[XB_TMO], 1u); break; } } } } while (0)

struct XcdBarrier {
    unsigned* bar; unsigned x;
    volatile LAS unsigned* st;
};

__device__ __forceinline__ XcdBarrier xcd_barrier_post(unsigned* bar, volatile LAS unsigned* st) {
    XcdBarrier b; b.bar = bar; b.x = xb_xcc_id(); b.st = st;
    if (threadIdx.x == 0) (void)xb_add(&bar[XB_XCNT(b.x)], 1u);
    return b;
}
__device__ __forceinline__ void xcd_barrier_complete(unsigned* bar, unsigned x, unsigned& nloc, unsigned& nx) {
    const unsigned G = gridDim.x * gridDim.y * gridDim.z;
    unsigned sum, cnt, mine, sp = 0u;
    for (;;) {
        sum = 0u; cnt = 0u; mine = 0u;
#pragma unroll
        for (unsigned j = 0; j < 16; ++j) { const unsigned c = xb_ld(&bar[XB_XCNT(j)]); sum += c; cnt += (c > 0u) ? 1u : 0u; mine = (j == x) ? c : mine; }
        if (sum == G) break;
        __builtin_amdgcn_s_sleep(1);
        if ((++sp & 255u) == 0u) { if (xb_ld(&bar[XB_TMO])) break; if (sp > XB_SPIN_CAP) { atomicAdd(&bar[XB_TMO], 1u); break; } }
    }
    nloc = mine > 0u ? mine : 1u; nx = cnt > 0u ? cnt : 1u;
}

__device__ __forceinline__ void xcd_barrier(const XcdBarrier& b) {
    asm volatile("s_waitcnt vmcnt(0)" ::: "memory");
    __syncthreads();
    if (threadIdx.x == 0) {
        unsigned* bar = b.bar;
        __builtin_amdgcn_s_waitcnt(0);
        unsigned nloc = b.st[0], nx = b.st[1];
        if (nloc == 0u) { xcd_barrier_complete(bar, b.x, nloc, nx); b.st[0] = nloc; b.st[1] = nx; }
        const unsigned old = xb_add(&bar[XB_XSUB(b.x)], 1u);
        const unsigned gen = old / nloc;
        if (old + 1u == (gen + 1u) * nloc) {
            __builtin_amdgcn_fence(__ATOMIC_RELEASE, "agent");
            asm volatile("s_waitcnt vmcnt(0)" ::: "memory");
            const unsigned og = xb_add(&bar[XB_TOP], 1u);
            const unsigned tg = og / nx;
            if (og + 1u == (tg + 1u) * nx) xb_add(&bar[XB_TOPGEN], 1u);
            else XB_SPIN(xb_ld(&bar[XB_TOPGEN]) == tg, bar);
            __builtin_amdgcn_fence(__ATOMIC_ACQUIRE, "agent");
            xb_add(&bar[XB_XGEN(b.x)], 1u);
            asm volatile("s_waitcnt vmcnt(0)" ::: "memory");
        } else {
            XB_SPIN(xb_ld(&bar[XB_XGEN(b.x)]) == gen, bar);
            __builtin_amdgcn_fence(__ATOMIC_ACQUIRE, "agent");
            asm volatile("s_waitcnt vmcnt(0)" ::: "memory");
        }
    }
    __syncthreads();
}

__device__ __forceinline__ void tr_item(const float* W, int ldw, int K, bf16* WT, int dst0, int src0, int k0, const float* gain, int nvalid, float wscale, LAS float* scr, int lane) {
#pragma unroll 8
    for (int i = 0; i < 32; ++i) { const int kk = 2 * i + (lane >> 5); float v = ((lane & 31) < nvalid) ? __builtin_nontemporal_load(&W[(size_t)(k0 + kk) * ldw + src0 + (lane & 31)]) : 0.f;     if (gain) v *= gain[k0 + kk]; scr[kk * 33 + (lane & 31)] = v * wscale; }
    LDS_WAIT(); asm volatile("" ::: "memory");
    const int c = lane & 7;
#pragma unroll
    for (int j = 0; j < 4; ++j) { const int n = (lane >> 3) + 8 * j; const LAS float* s = scr + (8 * c) * 33 + n;
        v4u o; o.x = pk2(s[0 * 33], s[1 * 33]); o.y = pk2(s[2 * 33], s[3 * 33]); o.z = pk2(s[4 * 33], s[5 * 33]); o.w = pk2(s[6 * 33], s[7 * 33]);
        *(v4u*)(WT + (size_t)(dst0 + n) * K + k0 + 8 * c) = o; }
    LDS_WAIT(); asm volatile("" ::: "memory");
}
__device__ __forceinline__ int srcmap(int kind, int c0) {
    const int pn = c0 >> 8, p = c0 & 255;
    if (kind == 1) return (p >> 7) * FF + 128 * pn + (p & 127);
    if (kind == 2) return 256 * pn + 64 * ((p >> 5) & 3) + 32 * (p >> 7);
    return c0;
}
__device__ __forceinline__ bool tr_matrix(int& it, const float* W, int ldw, int K, int ndst, bf16* WT, int kind, const float* gain, LAS float* scr, int lane) {
    const int nblk = ndst / 32, nit = (K / 64) * nblk;
    if (it >= nit) { it -= nit; return false; }
    const int kb = it / nblk, nb = it % nblk;
    int src0 = srcmap(kind == 3 ? 2 : kind, 32 * nb), nvalid = 32;
    if (kind == 3 && nb >= 64) { src0 = (nb == 64) ? 2048 : 0; nvalid = (nb == 64) ? 16 : 0; }
    const float wscale = (kind == 1) ? ((((32 * nb) >> 7) & 1) ? (1.0f / LOG2E) : LOG2E) : 1.0f;
    tr_item(W, ldw, K, WT, 32 * nb, src0, 64 * kb, gain, nvalid, wscale, scr, lane);
    return true;
}

__device__ __forceinline__ void norm_rows(const float* src, const float* g, bf16* dst, int gw, int NGW, int lane) {
    f32x4 gv[4];
#pragma unroll
    for (int j = 0; j < 4; ++j) gv[j] = *(const f32x4*)(g + 4 * lane + 256 * j);
    for (int m = gw; m < M; m += NGW) {
        const f32x4* xr = (const f32x4*)(src + (size_t)m * DM) + lane; f32x4 v[4]; float s = 0.f;
#pragma unroll
        for (int j = 0; j < 4; ++j) { v[j] = xr[64 * j]; s += (v[j].x * v[j].x + v[j].y * v[j].y) + (v[j].z * v[j].z + v[j].w * v[j].w); }
        const float rstd = 1.0f / sqrtf(wave_sum(s) * (1.0f / DM) + EPS);
        v2u* o8 = (v2u*)(dst + (size_t)m * DM) + lane;
#pragma unroll
        for (int j = 0; j < 4; ++j) { const f32x4 y = v[j] * rstd * gv[j]; v2u w; w.x = pk2(y.x, y.y); w.y = pk2(y.z, y.w); o8[64 * j] = w; }
    }
}

struct BandUnit { bf16* q; bf16* k; bf16* v; long P; int NT, qoff, g, head; size_t row0; };
__device__ __forceinline__ BandUnit band_unit(int un, bf16* QKV, int gmode) {
    BandUnit r; const int uu = un & 15, head = (un >> 4) & 15, rest = un >> 8, g = gmode ? 2 : (rest & 1), bl = gmode ? rest : (rest >> 1);
    const int dil = (g == 0) ? 1 : (g == 1) ? 4 : 16, L = SEQ / dil;
    const int mglob = uu * 256, res = mglob / L, m0 = mglob % L;
    const int kb0 = m0 ? m0 - 128 : 0; r.NT = m0 ? 6 : 4; r.qoff = m0 ? 128 : 0; r.P = (long)dil * 64; r.g = g; r.head = head;
    bf16* base = QKV + ((size_t)((bl * 3 + g) * 3) * 16 + head) * (size_t)(SEQ * 64) + (size_t)res * 64;
    constexpr size_t WHICH = (size_t)16 * SEQ * 64;
    r.q = base + (size_t)m0 * r.P; r.k = base + WHICH + (size_t)kb0 * r.P; r.v = base + 2 * WHICH + (size_t)kb0 * r.P;
    r.row0 = (size_t)bl * SEQ + res + (size_t)m0 * dil;
    return r;
}
enum Op { OP_PRO = 0, OP_NORM, OP_FFN1, OP_FFN2, OP_QKV, OP_ATTA, OP_COMB, OP_WOA, OP_NORMKV, OP_KVFFN1, OP_QB, OP_FOX, OP_WOB };
constexpr int NPH = 19;

__global__ void __launch_bounds__(NTHREADS, 2) fwd_kernel(Params p) {
    extern __shared__ __attribute__((aligned(16))) unsigned char lds_raw[];
    cg::grid_group grid = cg::this_grid();
    LAS unsigned char* lds = (LAS unsigned char*)lds_raw;
    const int G = gridDim.x, bx = blockIdx.x;
    const int vcu = (G % 8 == 0) ? (bx % 8) * (G / 8) + bx / 8 : bx;
    const int NGW = G * NWAVES;
    unsigned char* ws = p.ws;
    bf16* XN = (bf16*)(ws + WS_XN); bf16* XN2 = (bf16*)(ws + WS_XN2); bf16* MIX = (bf16*)(ws + WS_MIX); bf16* ACT = (bf16*)(ws + WS_ACT); bf16* QKV = (bf16*)(ws + WS_QKV);
    bf16* QB = (bf16*)(ws + WS_QB); bf16* KB = (bf16*)(ws + WS_KB); bf16* VB = (bf16*)(ws + WS_VB);
    float* ROPE = (float*)(ws + WS_ROPE); float* LOGF = (float*)(ws + WS_LOGF); float* CUM = (float*)(ws + WS_CUM); float* LSE = (float*)(ws + WS_LSE); float* SS = (float*)(ws + WS_SS);
    float* out = p.out;
    if (threadIdx.x < 64) ((LAS unsigned*)(lds + 131072))[threadIdx.x] = 0u;
    __syncthreads();
    const XcdBarrier xbar = xcd_barrier_post((unsigned*)(ws + WS_BAR), (volatile LAS unsigned*)(lds + 131072) + 8);

#pragma unroll 1
    for (int ph = 0; ph < NPH; ++ph) {
        int tid = threadIdx.x; asm volatile("" : "+v"(tid));
        const int lane = tid & 63, wave = __builtin_amdgcn_readfirstlane(tid >> 6), gw = vcu * NWAVES + wave;
        int op, a = 0;
        switch (ph) {
            case 0: op = OP_PRO; break;
            case 1: op = OP_FFN1; a = 0; break;   case 2: op = OP_FFN2; a = 0; break;
            case 3: op = OP_QKV; a = 0; break;    case 4: op = OP_ATTA; a = 0; break;   case 5: op = OP_COMB; a = 0; break;
            case 6: op = OP_QKV; a = 1; break;    case 7: op = OP_ATTA; a = 1; break;   case 8: op = OP_COMB; a = 1; break;
            case 9: op = OP_WOA; break;
            case 10: op = OP_FFN1; a = 1; break;  case 11: op = OP_FFN2; a = 1; break;
            case 12: op = OP_KVFFN1; a = 2; break; case 13: op = OP_FFN2; a = 2; break;
            case 14: op = OP_QB; break;           case 15: op = OP_FOX; break;          case 16: op = OP_WOB; break;
            case 17: op = OP_FFN1; a = 3; break;  default: op = OP_FFN2; a = 3; break;
        }
        if (op == OP_PRO) {
            LAS float* scr = (LAS float*)(lds + wave * 16384);
            constexpr int I_IN = (DM / 64) * (FF2 / 32), I_OUT = (FF / 64) * (DM / 32), I_QKV = (DM / 64) * (NQKV / 32), I_SQ = (DM / 64) * (DM / 32), I_KV = (DM / 64) * (2304 / 32);
            constexpr int NITEMS = 4 * I_IN + 4 * I_OUT + I_QKV + 3 * I_SQ + I_KV;
            for (int it0 = gw; it0 < NITEMS; it0 += NGW) {
                int it = it0; bool done = false;
#pragma unroll 1
                for (int i = 0; i < 4 && !done; ++i) done = tr_matrix(it, p.ffn_w_in + (size_t)i * DM * FF2, FF2, DM, FF2, (bf16*)(ws + WS_WIN + i * WIN_SZ), 1, p.ffn_norm + i * DM, scr, lane);
#pragma unroll 1
                for (int i = 0; i < 4 && !done; ++i) done = tr_matrix(it, p.ffn_w_out + (size_t)i * FF * DM, DM, FF, DM, (bf16*)(ws + WS_WOUT + i * WOUT_SZ), 0, nullptr, scr, lane);
                if (!done) done = tr_matrix(it, p.a_w_qkv, NQKV, DM, NQKV, (bf16*)(ws + WS_WQKV), 2, p.mix_norm, scr, lane);
                if (!done) done = tr_matrix(it, p.a_w_o, DM, DM, DM, (bf16*)(ws + WS_WAO), 0, nullptr, scr, lane);
                if (!done) done = tr_matrix(it, p.kv_w, 2064, DM, 2304, (bf16*)(ws + WS_WKV), 3, p.kv_norm, scr, lane);
                if (!done) done = tr_matrix(it, p.b_w_q, DM, DM, DM, (bf16*)(ws + WS_WBQ), 2, p.mix_norm + DM, scr, lane);
                if (!done) done = tr_matrix(it, p.b_w_o, DM, DM, DM, (bf16*)(ws + WS_WBO), 0, nullptr, scr, lane);
            }
            for (int m = bx * NTHREADS + tid; m < M; m += G * NTHREADS) {
                const float pf = (float)p.pos[m]; float cs[16];
#pragma unroll
                for (int f = 0; f < 8; ++f) { const float ang = pf * p.invf[f];
                    double r = (double)ang * 0.15915494309189535; r -= floor(r); const float rf = (float)r;
                    cs[f] = __builtin_amdgcn_cosf(rf); cs[8 + f] = __builtin_amdgcn_sinf(rf); }
#pragma unroll
                for (int f = 0; f < 4; ++f) *(f32x4*)(ROPE + (size_t)m * 16 + 4 * f) = (f32x4){cs[4 * f], cs[4 * f + 1], cs[4 * f + 2], cs[4 * f + 3]};
            }
            for (int mrow = gw; mrow < M; mrow += NGW) {
                const f32x4* xr = (const f32x4*)(p.x + (size_t)mrow * DM) + lane; f32x4 v[4]; float s = 0.f;
#pragma unroll
                for (int j = 0; j < 4; ++j) { v[j] = __builtin_nontemporal_load(&xr[64 * j]); s += (v[j].x * v[j].x + v[j].y * v[j].y) + (v[j].z * v[j].z + v[j].w * v[j].w); }
                s = wave_sum(s);
                v2u* o8 = (v2u*)(XN + (size_t)mrow * DM) + lane;
#pragma unroll
                for (int j = 0; j < 4; ++j) { v2u w; w.x = pk2(v[j].x, v[j].y); w.y = pk2(v[j].z, v[j].w); o8[64 * j] = w; }
                if (lane < 16) SS[(size_t)mrow * 16 + lane] = (lane == 0) ? s : 0.f;
            }
        }
        if (op == OP_QKV || op == OP_KVFFN1 || op == OP_QB) {
            pg8::Gemm g; pg8::EpiHead E;
            if (op == OP_QKV) { g = pg8::Gemm{XN + (size_t)a * HALF_M * DM, (const bf16*)(ws + WS_WQKV), HALF_M, NQKV, DM};
                E = pg8::EpiHead{QKV, nullptr, NQKV, p.a_q_norm, p.a_k_norm, ROPE, a * HALF_M, 0, C2, SS, nullptr, nullptr, (LAS float*)(lds + LDS_SS_OFF)}; }
            else if (op == OP_KVFFN1) { g = pg8::Gemm{XN, (const bf16*)(ws + WS_WKV), M, 2304, DM};
                E = pg8::EpiHead{KB, VB, DM, nullptr, p.kv_k_norm, ROPE, 0, 1, 1.0f, SS, p.kv_b_f, LOGF, (LAS float*)(lds + LDS_SS_OFF)}; }
            else { g = pg8::Gemm{XN, (const bf16*)(ws + WS_WBQ), M, DM, DM};
                E = pg8::EpiHead{QB, nullptr, DM, p.b_q_norm, nullptr, ROPE, 0, 2, C2, SS, nullptr, nullptr, (LAS float*)(lds + LDS_SS_OFF)}; }
            pg8::StaticOrder S; S.init(g.M, g.N, G, bx);
#ifndef NO_HEAD
            pg8::gemm_phase<pg8::EpiHead, pg8::StaticOrder, true, true>(lds, g, S, E);
#endif
        }
        if (ph == 13) {
#ifndef NO_SCAN
            if (wave == 0) for (int sidx = vcu; sidx < NB * NH; sidx += G) {
                const int b = sidx >> 4, h = sidx & 15; const float* src = LOGF + ((size_t)b * SEQ + 64 * lane) * 16 + h;
                float v[64]; float tot = 0.f;
#pragma unroll
                for (int i = 0; i < 64; ++i) v[i] = src[(size_t)i * 16];
#pragma unroll
                for (int i = 0; i < 64; ++i) tot += v[i];
                float inc = tot;
#pragma unroll
                for (int o = 1; o < 64; o <<= 1) { const float t = __shfl_up(inc, o); if (lane >= o) inc += t; }
                float run = inc - tot; float* dst = CUM + (size_t)sidx * SEQ + 64 * lane;
#pragma unroll
                for (int i = 0; i < 64; i += 4) { f32x4 o4; run += v[i]; o4.x = run * LOG2E; run += v[i + 1]; o4.y = run * LOG2E; run += v[i + 2]; o4.z = run * LOG2E; run += v[i + 3]; o4.w = run * LOG2E; *(f32x4*)(dst + i) = o4; }
            }
#endif
        }
        if (op == OP_FFN1 || op == OP_KVFFN1) {
            pg8::Gemm g{XN, (const bf16*)(ws + WS_WIN + a * WIN_SZ), M, FF2, DM};
            pg8::StaticOrder S; S.init(M, FF2, G, bx); pg8::EpiSwiglu E{ACT, FF, SS, (LAS float*)(lds + LDS_SS_OFF)};
#ifndef NO_SWI
            pg8::gemm_phase<pg8::EpiSwiglu, pg8::StaticOrder, true, true>(lds, g, S, E);
#endif
        }
        if (op == OP_FFN2 || op == OP_WOA || op == OP_WOB) {
            pg8::Gemm g; pg8::EpiResF32 E;
            if (op == OP_FFN2) { g = pg8::Gemm{ACT, (const bf16*)(ws + WS_WOUT + a * WOUT_SZ), M, DM, FF}; E = (ph == 2) ? pg8::EpiResF32{p.x, nullptr, nullptr, XN, DM, 0.5f, SS} : (ph == NPH - 1) ? pg8::EpiResF32{nullptr, XN, out, nullptr, DM, 0.5f, SS} : pg8::EpiResF32{nullptr, XN, nullptr, XN, DM, 0.5f, SS}; }
            else if (op == OP_WOA) { g = pg8::Gemm{MIX, (const bf16*)(ws + WS_WAO), M, DM, DM}; E = pg8::EpiResF32{nullptr, XN, nullptr, XN, DM, 1.0f, SS}; }
            else { g = pg8::Gemm{QB, (const bf16*)(ws + WS_WBO), M, DM, DM}; E = pg8::EpiResF32{nullptr, XN, nullptr, XN, DM, 1.0f, SS}; }
            pg8::StaticOrder S; S.init(M, DM, G, bx);
#ifndef NO_RES
            pg8::gemm_phase<pg8::EpiResF32, pg8::StaticOrder, true, true>(lds, g, S, E);
#endif
        }
#ifndef NO_ATTA
        bool band_nomax = false;
        if (op == OP_ATTA || op == OP_COMB) {
            float gq = 0.f, gk = 0.f;
            for (int d = 0; d < 192; ++d) { gq = fmaxf(gq, fabsf(p.a_q_norm[d])); gk = fmaxf(gk, fabsf(p.a_k_norm[d])); }
            band_nomax = (C2 * 64.0f * gq * gk * 1.03f + 0.5f) < 60.0f;
        }
        if (op == OP_ATTA) {
            constexpr int NU = 8 * 2 * 16 * 16;
            bool pre = false;
            for (int un = vcu; un < NU; un += G) {
                BandUnit cu_ = band_unit(un, QKV, 0), nx_ = band_unit(un + G < NU ? un + G : un, QKV, 0); const bool has_next = un + G < NU;
                float* lse = LSE + ((size_t)cu_.g * HALF_M + cu_.row0) * 16 + cu_.head;
                if (band_nomax) attn_body::attn_unit<1, 8, false, true>((const attn_body::bf16*)cu_.q, (const attn_body::bf16*)cu_.k, (const attn_body::bf16*)cu_.v, (attn_body::bf16*)cu_.q, cu_.P, cu_.NT, cu_.qoff, nullptr, lse, cu_.P / 4, (char*)lds_raw,
                                           pre, has_next ? (const attn_body::bf16*)nx_.q : nullptr, has_next ? (const attn_body::bf16*)nx_.k : nullptr, nx_.P);
                else attn_body::attn_unit<1, 8>((const attn_body::bf16*)cu_.q, (const attn_body::bf16*)cu_.k, (const attn_body::bf16*)cu_.v, (attn_body::bf16*)cu_.q, cu_.P, cu_.NT, cu_.qoff, nullptr, lse, cu_.P / 4, (char*)lds_raw,
                                           pre, has_next ? (const attn_body::bf16*)nx_.q : nullptr, has_next ? (const attn_body::bf16*)nx_.k : nullptr, nx_.P);
                pre = has_next;
            }
        }
        if (op == OP_COMB) {
            constexpr int NU = 8 * 16 * 16;
            bool pre = false;
            for (int un = vcu; un < NU; un += G) {
                BandUnit cu_ = band_unit(un, QKV, 1), nx_ = band_unit(un + G < NU ? un + G : un, QKV, 1); const bool has_next = un + G < NU;
                float* lse = LSE + ((size_t)2 * HALF_M + cu_.row0) * 16 + cu_.head;
                bf16* mixp = MIX + ((size_t)a * HALF_M + cu_.row0) * DM + cu_.head * 64;
                if (band_nomax) attn_body::attn_unit<1, 8, true, true>((const attn_body::bf16*)cu_.q, (const attn_body::bf16*)cu_.k, (const attn_body::bf16*)cu_.v, (attn_body::bf16*)cu_.q, cu_.P, cu_.NT, cu_.qoff, nullptr, lse, cu_.P / 4, (char*)lds_raw,
                                                 pre, has_next ? (const attn_body::bf16*)nx_.q : nullptr, has_next ? (const attn_body::bf16*)nx_.k : nullptr, nx_.P,
                                                 (attn_body::bf16*)mixp, cu_.P * 16, (long)HALF_M * 16, (long)3 * 16 * SEQ * 64);
                else attn_body::attn_unit<1, 8, true>((const attn_body::bf16*)cu_.q, (const attn_body::bf16*)cu_.k, (const attn_body::bf16*)cu_.v, (attn_body::bf16*)cu_.q, cu_.P, cu_.NT, cu_.qoff, nullptr, lse, cu_.P / 4, (char*)lds_raw,
                                                 pre, has_next ? (const attn_body::bf16*)nx_.q : nullptr, has_next ? (const attn_body::bf16*)nx_.k : nullptr, nx_.P,
                                                 (attn_body::bf16*)mixp, cu_.P * 16, (long)HALF_M * 16, (long)3 * 16 * SEQ * 64);
                pre = has_next;
            }
        }
#endif
#ifndef NO_FOX
        if (op == OP_FOX) {
            LAS float* cumL = (LAS float*)(lds + attn_body::ATTN_LDS_BYTES);
            float gqm = 0.f, gkm = 0.f;
            for (int d = 0; d < 64; ++d) { gqm = fmaxf(gqm, fabsf(p.b_q_norm[d])); gkm = fmaxf(gkm, fabsf(p.kv_k_norm[d])); }
            const float skip_thr = -(160.0f + 2.0f * (C2 * 64.0f * gqm * gkm * 1.03f + 0.5f));
            const bool fox_nomax = (C2 * 64.0f * gqm * gkm * 1.03f + 0.5f) < 60.0f;
            for (int sidx = vcu; sidx < NB * NH; sidx += G) {
                for (int i = tid; i < SEQ / 4; i += NTHREADS) ((LAS f32x4*)cumL)[i] = ((const f32x4*)(CUM + (size_t)sidx * SEQ))[i];
                __syncthreads();
                const int b = sidx >> 4, h = sidx & 15; const size_t base = (size_t)b * SEQ * DM + h * 64;
                bool pre = false;
                int ts_cur; { const int NT = 64, q0 = 15 * 256; int ts = 0; const float cq0 = cumL[q0];
                    while (ts + 2 <= NT - 4 && cq0 - cumL[64 * (ts + 2) - 1] < skip_thr) ts += 2;
                    ts_cur = __builtin_amdgcn_readfirstlane(ts); }
#pragma unroll 1
                for (int qb = 15; qb >= 0; --qb) {
                    bf16* qp = QB + base + (size_t)qb * 256 * DM;
                    const int NT = 4 * qb + 4, q0 = qb * 256, ts = ts_cur;
                    int ts_n = 0; const bool has_next = qb > 0;
                    if (has_next) { const int NTn = 4 * qb, q0n = (qb - 1) * 256; const float cq0 = cumL[q0n];
                        while (ts_n + 2 <= NTn - 4 && cq0 - cumL[64 * (ts_n + 2) - 1] < skip_thr) ts_n += 2;
                        ts_n = __builtin_amdgcn_readfirstlane(ts_n); }
                    const size_t ko = (size_t)ts * 64 * DM, kon = (size_t)ts_n * 64 * DM;
                    if (fox_nomax) attn_body::attn_unit<0, 8, false, true>((const attn_body::bf16*)qp, (const attn_body::bf16*)(KB + base + ko), (const attn_body::bf16*)(VB + base + ko), (attn_body::bf16*)qp, (long)DM, NT - ts, q0 - 64 * ts,
                                               cumL + 64 * ts, nullptr, 0, (char*)lds_raw, pre,
                                               has_next ? (const attn_body::bf16*)(qp - (size_t)256 * DM) : nullptr, has_next ? (const attn_body::bf16*)(KB + base + kon) : nullptr, (long)DM);
                    else attn_body::attn_unit<0, 8>((const attn_body::bf16*)qp, (const attn_body::bf16*)(KB + base + ko), (const attn_body::bf16*)(VB + base + ko), (attn_body::bf16*)qp, (long)DM, NT - ts, q0 - 64 * ts,
                                               cumL + 64 * ts, nullptr, 0, (char*)lds_raw, pre,
                                               has_next ? (const attn_body::bf16*)(qp - (size_t)256 * DM) : nullptr, has_next ? (const attn_body::bf16*)(KB + base + kon) : nullptr, (long)DM);
                    pre = has_next; ts_cur = ts_n;
                }
                __syncthreads();
            }
        }
#endif
        if (ph + 1 < NPH) { if (ph == 0) grid.sync(); else xcd_barrier(xbar); }
    }
}

extern "C" void kernel_launch(void* const* d_in, const int* in_sizes, int n_in, void* d_out, int out_size, void* d_ws, size_t ws_size, hipStream_t stream) {
    static int grid = 0;
    if (grid == 0) {
        if (n_in != 17 || in_sizes[0] != M * DM || out_size != M * DM || ws_size < WS_END) { fprintf(stderr, "kernel_launch: unexpected shapes/workspace (n_in %d, ws %zu)\n", n_in, ws_size); grid = -1; return; }
        int dev = 0, cus = 0;
        if (hipGetDevice(&dev) != hipSuccess || hipDeviceGetAttribute(&cus, hipDeviceAttributeMultiprocessorCount, dev) != hipSuccess) { grid = -1; return; }
        if (hipFuncSetAttribute((const void*)fwd_kernel, hipFuncAttributeMaxDynamicSharedMemorySize, LDS_BYTES) != hipSuccess) { fprintf(stderr, "kernel_launch: hipFuncSetAttribute failed\n"); grid = -1; return; }
        int per_cu = 0;
        if (hipOccupancyMaxActiveBlocksPerMultiprocessor(&per_cu, (const void*)fwd_kernel, NTHREADS, LDS_BYTES) != hipSuccess || per_cu < 1) { fprintf(stderr, "kernel_launch: occupancy query says %d\n", per_cu); per_cu = 1; }
        (void)hipGetLastError();
        grid = cus;
    }
    if (grid < 0) return;
    Params p{};
    p.x = (const float*)d_in[0]; p.pos = (const int*)d_in[1]; p.ffn_norm = (const float*)d_in[2]; p.ffn_w_in = (const float*)d_in[3]; p.ffn_w_out = (const float*)d_in[4];
    p.mix_norm = (const float*)d_in[5]; p.a_w_qkv = (const float*)d_in[6]; p.a_q_norm = (const float*)d_in[7]; p.a_k_norm = (const float*)d_in[8]; p.a_w_o = (const float*)d_in[9];
    p.kv_norm = (const float*)d_in[10]; p.kv_w = (const float*)d_in[11]; p.kv_b_f = (const float*)d_in[12]; p.kv_k_norm = (const float*)d_in[13];
    p.b_w_q = (const float*)d_in[14]; p.b_q_norm = (const float*)d_in[15]; p.b_w_o = (const float*)d_in[16];
    p.out = (float*)d_out; p.ws = (unsigned char*)d_ws;
    for (int i = 0; i < 8; ++i) p.invf[i] = (float)pow(500000.0, -(double)i / 8.0);
    if (hipMemsetAsync(d_ws, 0, CTL_ZERO_BYTES, stream) != hipSuccess) { fprintf(stderr, "kernel_launch: memset failed\n"); return; }
    void* args[] = {&p};
    hipError_t e = hipLaunchCooperativeKernel((const void*)fwd_kernel, dim3(grid), dim3(NTHREADS), args, LDS_BYTES, stream);
    if (e != hipSuccess) fprintf(stderr, "kernel_launch: cooperative launch failed: %s (grid %d)\n", hipGetErrorString(e), grid);
}
```

```cpp
#include <hip/hip_runtime.h>
#include <hip/hip_cooperative_groups.h>
#include <cstdio>
#include <cstdint>
#include <cmath>
namespace cg = cooperative_groups;
namespace pg8 {
#define PG8_LAS __attribute__((address_space(3)))
typedef unsigned short bf16_t;
typedef short bf16x8 __attribute__((ext_vector_type(8)));
typedef float f32x4 __attribute__((ext_vector_type(4)));
typedef unsigned u32x4 __attribute__((ext_vector_type(4)));
constexpr int BM = 256, BK = 64, HALF = 128, HTB = HALF * BK * 2  , STAGE_BYTES = 8 * HTB, NXCD = 8, WGM = 8;

__host__ __device__ __forceinline__ int lds_byte(int r, int c) { const int st = (r >> 4) * 2 + (c >> 5), rr = r & 15, cc = c & 31, ob = rr * 64 + cc * 2; return st * 1024 + (ob ^ (((ob >> 9) & 1) << 5)); }
__host__ __device__ __forceinline__ void stage_rc(int b, int& R, int& C) { const int st = b / 1024, sb = b % 1024, swz = sb ^ (((sb >> 9) & 1) << 5); R = (st >> 1) * 16 + swz / 64; C = (st & 1) * 32 + (swz % 64) / 2; }
__host__ __device__ __forceinline__ int perm32(int rho) { const int n = rho >> 4, i = rho & 15; return 8 * (i >> 2) + 4 * n + (i & 3); }

struct Unit { int pm, pn; };
struct Gemm { const bf16_t* A; const bf16_t* Bt; int M, N, K; };

struct StaticOrder {
    int nM, nN, nwg, G, c;
    __host__ __device__ void init(int M, int N, int G_, int c_) { nM = M / BM; nN = N / BM; nwg = nM * nN; G = G_; c = c_; }
    __host__ __device__ bool next(int i, Unit& u) const {
        const long L = (long)i * G + c; if (L >= nwg) return false;
        int wgid = (int)L; { const int q = nwg / NXCD, r = nwg % NXCD, xcd = wgid % NXCD, off = wgid / NXCD; wgid = (xcd < r ? xcd * (q + 1) : r * (q + 1) + (xcd - r) * q) + off; }
        const int nig = WGM * nN, gid = wgid / nig, fm = gid * WGM, gsz = (nM - fm) < WGM ? (nM - fm) : WGM;
        u.pm = fm + ((wgid % nig) % gsz); u.pn = (wgid % nig) / gsz; return true;
    }
    __device__ __forceinline__ void a_ready(const Unit&) const {}
    __device__ __forceinline__ void done(const Unit&) const {}
};

__device__ __forceinline__ unsigned cvt_pk_bf16(float lo, float hi) { unsigned r; asm volatile("v_cvt_pk_bf16_f32 %0, %1, %2" : "=v"(r) : "v"(lo), "v"(hi)); return r; }
typedef float f32x2 __attribute__((ext_vector_type(2)));
__device__ __forceinline__ float swiglu_f(float g2, float u2) { return (g2 * u2) * __builtin_amdgcn_rcpf(1.0f + __builtin_amdgcn_exp2f(-g2)); }
__device__ __forceinline__ float sum_fq(float v) {
    auto a = __builtin_amdgcn_permlane32_swap(__float_as_uint(v), __float_as_uint(v), false, false); v = __uint_as_float(a[0]) + __uint_as_float(a[1]);
    auto b = __builtin_amdgcn_permlane16_swap(__float_as_uint(v), __float_as_uint(v), false, false); return __uint_as_float(b[0]) + __uint_as_float(b[1]);
}
__device__ __forceinline__ float xor16(float v, int fq) {
    auto b = __builtin_amdgcn_permlane16_swap(__float_as_uint(v), __float_as_uint(v), false, false); return __uint_as_float((fq & 1) ? b[0] : b[1]);
}
__device__ __forceinline__ float row_rstd(const float* ss, int row, int fq) {
    const f32x4 v = *(const f32x4*)(ss + (size_t)row * 16 + 4 * fq); float s = (v[0] + v[1]) + (v[2] + v[3]);
    s += __shfl_xor(s, 16); s += __shfl_xor(s, 32);
    return 1.0f / sqrtf(s * (1.0f / 1024.0f) + 1e-6f);
}
__device__ __forceinline__ void ss_prefetch(const float* ss, size_t row0, PG8_LAS float* sl, int wid, int lane) {
    const char* g = (const char*)(ss + row0 * 16) + wid * 2048 + lane * 16; PG8_LAS char* d = (PG8_LAS char*)sl + wid * 2048;
    __builtin_amdgcn_global_load_lds((const unsigned*)g, (PG8_LAS unsigned*)d, 16, 0, 0);
    __builtin_amdgcn_global_load_lds((const unsigned*)(g + 1024), (PG8_LAS unsigned*)(d + 1024), 16, 0, 0);
}
__device__ __forceinline__ void rows_rstd_lds(float (&rs)[2][4], const PG8_LAS float* sl, int rl0, int fq) {
    f32x4 v[2][4];
#pragma unroll
    for (int ai = 0; ai < 2; ++ai)
#pragma unroll
        for (int m = 0; m < 4; ++m) v[ai][m] = *(const PG8_LAS f32x4*)(sl + (rl0 + ai * HALF + m * 16) * 16 + 4 * fq);
#pragma unroll
    for (int ai = 0; ai < 2; ++ai)
#pragma unroll
        for (int m = 0; m < 4; ++m) { float s = (v[ai][m][0] + v[ai][m][1]) + (v[ai][m][2] + v[ai][m][3]); s = sum_fq(s); rs[ai][m] = __builtin_amdgcn_rsqf(s * (1.0f / 1024.0f) + 1e-6f); }
}
__device__ __forceinline__ void rows_rstd(float (&rs)[2][4], const float* ss, int row0, int fq) {
    f32x4 v[2][4];
#pragma unroll
    for (int ai = 0; ai < 2; ++ai)
#pragma unroll
        for (int m = 0; m < 4; ++m) v[ai][m] = *(const f32x4*)(ss + (size_t)(row0 + ai * HALF + m * 16) * 16 + 4 * fq);
#pragma unroll
    for (int ai = 0; ai < 2; ++ai)
#pragma unroll
        for (int m = 0; m < 4; ++m) { float s = (v[ai][m][0] + v[ai][m][1]) + (v[ai][m][2] + v[ai][m][3]); s = sum_fq(s); rs[ai][m] = __builtin_amdgcn_rsqf(s * (1.0f / 1024.0f) + 1e-6f); }
}
struct EpiSwiglu {
    static constexpr bool PERM = true, AFTER_DRAIN = false;
    bf16_t* O; int ldc; const float* ss; PG8_LAS float* sl;
    __device__ __forceinline__ void prefetch(const Unit& u, int wid, int lane) const { ss_prefetch(ss, (size_t)u.pm * BM, sl, wid, lane); }
    __device__ __forceinline__ void operator()(const f32x4 (&acc)[2][2][4][2], const Unit& u, int wr, int wc, int fr, int fq) const {
        const int row0 = u.pm * BM + wr * 64 + fr; const int col0 = u.pn * HALF + wc * 32 + 8 * fq;
        float rsv[2][4]; rows_rstd_lds(rsv, sl, wr * 64 + fr, fq);
#pragma unroll
        for (int ai = 0; ai < 2; ++ai)
#pragma unroll
            for (int m = 0; m < 4; ++m) { bf16_t* rowp = O + (size_t)(row0 + ai * HALF + m * 16) * ldc + col0;
                const float rs = rsv[ai][m];
                const f32x4 g0 = acc[ai][0][m][0] * rs, g1 = acc[ai][0][m][1] * rs, u0 = acc[ai][1][m][0] * rs, u1 = acc[ai][1][m][1] * rs;
                u32x4 w; w.x = cvt_pk_bf16(swiglu_f(g0[0], u0[0]), swiglu_f(g0[1], u0[1])); w.y = cvt_pk_bf16(swiglu_f(g0[2], u0[2]), swiglu_f(g0[3], u0[3]));
                w.z = cvt_pk_bf16(swiglu_f(g1[0], u1[0]), swiglu_f(g1[1], u1[1])); w.w = cvt_pk_bf16(swiglu_f(g1[2], u1[2]), swiglu_f(g1[3], u1[3]));
                *(u32x4*)rowp = w; }
    }
};
struct EpiResF32 {
    static constexpr bool PERM = true, AFTER_DRAIN = false;
    const float* resf; const bf16_t* resb; float* outf; bf16_t* outb; int ldc; float s; float* ss;
    __device__ __forceinline__ void prefetch(const Unit&, int, int) const {}
    __device__ __forceinline__ void operator()(const f32x4 (&acc)[2][2][4][2], const Unit& u, int wr, int wc, int fr, int fq) const {
        const int col0 = u.pn * BM + wc * 32 + 8 * fq;
#pragma unroll
        for (int ai = 0; ai < 2; ++ai) {
            f32x4 rv[4][2][2];
            if (resf) {
#pragma unroll
                for (int m = 0; m < 4; ++m) { const size_t off = (size_t)(u.pm * BM + ai * HALF + wr * 64 + m * 16 + fr) * ldc + col0;
#pragma unroll
                    for (int bj = 0; bj < 2; ++bj)
#pragma unroll
                        for (int n = 0; n < 2; ++n) rv[m][bj][n] = *(const f32x4*)(resf + off + bj * HALF + n * 4); }
            } else {
                u32x4 rb[4][2];
#pragma unroll
                for (int m = 0; m < 4; ++m) { const size_t off = (size_t)(u.pm * BM + ai * HALF + wr * 64 + m * 16 + fr) * ldc + col0;
#pragma unroll
                    for (int bj = 0; bj < 2; ++bj) rb[m][bj] = *(const u32x4*)(resb + off + bj * HALF); }
#pragma unroll
                for (int m = 0; m < 4; ++m)
#pragma unroll
                    for (int bj = 0; bj < 2; ++bj) { const u32x4 w = rb[m][bj];
                        rv[m][bj][0] = (f32x4){__uint_as_float(w.x << 16), __uint_as_float(w.x & 0xffff0000u), __uint_as_float(w.y << 16), __uint_as_float(w.y & 0xffff0000u)};
                        rv[m][bj][1] = (f32x4){__uint_as_float(w.z << 16), __uint_as_float(w.z & 0xffff0000u), __uint_as_float(w.w << 16), __uint_as_float(w.w & 0xffff0000u)}; }
            }
#pragma unroll
            for (int m = 0; m < 4; ++m) { const int row = u.pm * BM + ai * HALF + wr * 64 + m * 16 + fr; const size_t off = (size_t)row * ldc + col0; float q = 0.f;
#pragma unroll
                for (int bj = 0; bj < 2; ++bj) { const f32x4 o0 = rv[m][bj][0] + acc[ai][bj][m][0] * s, o1 = rv[m][bj][1] + acc[ai][bj][m][1] * s;
                    if (outf) { *(f32x4*)(outf + off + bj * HALF) = o0; *(f32x4*)(outf + off + bj * HALF + 4) = o1; }
                    else { q += ((o0[0] * o0[0] + o0[1] * o0[1]) + (o0[2] * o0[2] + o0[3] * o0[3])) + ((o1[0] * o1[0] + o1[1] * o1[1]) + (o1[2] * o1[2] + o1[3] * o1[3]));
                        u32x4 w; w.x = cvt_pk_bf16(o0[0], o0[1]); w.y = cvt_pk_bf16(o0[2], o0[3]); w.z = cvt_pk_bf16(o1[0], o1[1]); w.w = cvt_pk_bf16(o1[2], o1[3]); *(u32x4*)(outb + off + bj * HALF) = w; } }
                if (!outf) { q = sum_fq(q); if (fq == 0) ss[(size_t)row * 16 + 4 * u.pn + wc] = q; } }
            asm volatile("" ::: "memory");
        }
    }
};
struct EpiHead {
    static constexpr bool PERM = true, AFTER_DRAIN = false;
    bf16_t* O; bf16_t* O2; int ldc; const float* qg; const float* kg; const float* rope; int row_off; int mode; float qscale; const float* ss; const float* bf; float* logf; PG8_LAS float* sl;
    __device__ __forceinline__ void prefetch(const Unit& u, int wid, int lane) const { ss_prefetch(ss, (size_t)u.pm * BM + row_off, sl, wid, lane); }
    __device__ __forceinline__ void operator()(const f32x4 (&acc)[2][2][4][2], const Unit& u, int wr, int wc, int fr_, int fq_) const {
        int fr = fr_, fq = fq_; asm volatile("" : "+v"(fr), "+v"(fq));
        bool donorm, dorope; const float* gain; float sc = 1.f; bf16_t* base = O; int colt;
        if (mode == 0) { const int g = u.pn / 12, which = (u.pn % 12) >> 2; donorm = which < 2; dorope = donorm; gain = (which == 0 ? qg : kg) + 64 * g; if (which == 0) sc = qscale; colt = u.pn * BM; }
        else if (mode == 1) { donorm = u.pn < 4; dorope = false; gain = kg; if (u.pn >= 4) base = O2; colt = (u.pn & 3) * BM;
            if (u.pn == 8) {
                if (wc == 0 && fq < 2) {
                    const f32x4 b0 = *(const f32x4*)(bf + 8 * fq), b1 = *(const f32x4*)(bf + 8 * fq + 4);
#pragma unroll
                    for (int ai = 0; ai < 2; ++ai)
#pragma unroll
                        for (int m = 0; m < 4; ++m) { const int row = u.pm * BM + wr * 64 + fr + ai * HALF + m * 16;
                            const PG8_LAS float* sr = sl + (wr * 64 + fr + ai * HALF + m * 16) * 16;
                            const f32x4 sv0 = *(const PG8_LAS f32x4*)(sr), sv1 = *(const PG8_LAS f32x4*)(sr + 4), sv2 = *(const PG8_LAS f32x4*)(sr + 8), sv3 = *(const PG8_LAS f32x4*)(sr + 12);
                            const float tot = ((sv0[0] + sv0[1]) + (sv0[2] + sv0[3])) + ((sv1[0] + sv1[1]) + (sv1[2] + sv1[3])) + ((sv2[0] + sv2[1]) + (sv2[2] + sv2[3])) + ((sv3[0] + sv3[1]) + (sv3[2] + sv3[3]));
                            const float rs = __builtin_amdgcn_rsqf(tot * (1.0f / 1024.0f) + 1e-6f);
                            const f32x4 z0 = acc[ai][0][m][0] * rs + b0, z1 = acc[ai][0][m][1] * rs + b1; f32x4 l0, l1;
#pragma unroll
                            for (int j = 0; j < 4; ++j) { l0[j] = fminf(z0[j], 0.f) - log1pf(expf(-fabsf(z0[j]))); l1[j] = fminf(z1[j], 0.f) - log1pf(expf(-fabsf(z1[j]))); }
                            *(f32x4*)(logf + (size_t)row * 16 + 8 * fq) = l0; *(f32x4*)(logf + (size_t)row * 16 + 8 * fq + 4) = l1; }
                }
                return;
            } }
        else { donorm = true; dorope = false; gain = qg; sc = qscale; colt = u.pn * BM; }
        f32x4 gv[2][2];
#pragma unroll
        for (int bj = 0; bj < 2; ++bj)
#pragma unroll
            for (int n = 0; n < 2; ++n) gv[bj][n] = donorm ? *(const f32x4*)(gain + 32 * bj + 8 * fq + 4 * n) * sc : (f32x4){sc, sc, sc, sc};
        const int row0 = u.pm * BM + wr * 64 + fr;
        size_t rstride; bf16_t* cbase;
        if (mode == 0) { const int g = u.pn / 12, which = (u.pn % 12) >> 2, head = 4 * (u.pn & 3) + wc; const size_t bl = (size_t)(u.pm >> 4);
            rstride = 64; cbase = O + bl * (size_t)(9 * 16 * 4096 * 64) + (size_t)((g * 3 + which) * 16 + head) * (4096 * 64) + 8 * fq - bl * (size_t)(4096 * 64); }
        else { rstride = (size_t)ldc; cbase = base + colt + 64 * wc + 8 * fq; }
        float rsv[2][4]; rows_rstd_lds(rsv, sl, wr * 64 + fr, fq);
#pragma unroll
        for (int ai = 0; ai < 2; ++ai)
#pragma unroll
            for (int mp = 0; mp < 4; mp += 2) {
            f32x4 cs4[2][4];
            if (dorope) {
#pragma unroll
                for (int mm = 0; mm < 2; ++mm) { const float* cs = rope + (size_t)(row0 + ai * HALF + (mp + mm) * 16 + row_off) * 16;
#pragma unroll
                    for (int k = 0; k < 4; ++k) cs4[mm][k] = *(const f32x4*)(cs + 4 * k); } }
#pragma unroll
            for (int mm = 0; mm < 2; ++mm) { const int m = mp + mm; const int row = row0 + ai * HALF + m * 16;
                const float rs = rsv[ai][m];
                f32x4 v00 = acc[ai][0][m][0] * rs, v01 = acc[ai][0][m][1] * rs, v10 = acc[ai][1][m][0] * rs, v11 = acc[ai][1][m][1] * rs;
                if (donorm) {
                    float ss = (v00[0] * v00[0] + v00[1] * v00[1]) + (v00[2] * v00[2] + v00[3] * v00[3]);
                    ss += (v01[0] * v01[0] + v01[1] * v01[1]) + (v01[2] * v01[2] + v01[3] * v01[3]);
                    ss += (v10[0] * v10[0] + v10[1] * v10[1]) + (v10[2] * v10[2] + v10[3] * v10[3]);
                    ss += (v11[0] * v11[0] + v11[1] * v11[1]) + (v11[2] * v11[2] + v11[3] * v11[3]);
                    ss = sum_fq(ss);
                    const float rstd = __builtin_amdgcn_rsqf(ss * (1.0f / 64.0f) + 1e-6f);
                    v00 = v00 * rstd; v01 = v01 * rstd; v10 = v10 * rstd; v11 = v11 * rstd;
                }
                v00 = v00 * gv[0][0]; v01 = v01 * gv[0][1]; v10 = v10 * gv[1][0]; v11 = v11 * gv[1][1];
                if (dorope) {
                    f32x4 p0, p1;
#pragma unroll
                    for (int j = 0; j < 4; ++j) { p0[j] = xor16(v00[j], fq); p1[j] = xor16(v01[j], fq); }
                    const f32x4 c0 = cs4[mm][0], c1 = cs4[mm][1], s0 = cs4[mm][2], s1 = cs4[mm][3];
                    if (fq == 0) { v00 = v00 * c0 - p0 * s0; v01 = v01 * c1 - p1 * s1; }
                    else if (fq == 1) { v00 = v00 * c0 + p0 * s0; v01 = v01 * c1 + p1 * s1; }
                }
                bf16_t* rowp = cbase + (size_t)row * rstride;
                u32x4 w; w.x = cvt_pk_bf16(v00[0], v00[1]); w.y = cvt_pk_bf16(v00[2], v00[3]); w.z = cvt_pk_bf16(v01[0], v01[1]); w.w = cvt_pk_bf16(v01[2], v01[3]);
                *(u32x4*)rowp = w;
                w.x = cvt_pk_bf16(v10[0], v10[1]); w.y = cvt_pk_bf16(v10[2], v10[3]); w.z = cvt_pk_bf16(v11[0], v11[1]); w.w = cvt_pk_bf16(v11[2], v11[3]);
                *(u32x4*)(rowp + 32) = w; }
            asm volatile("" ::: "memory"); }
    }
};
template <class Epi, class Sched, bool ALIGN_EPI = false, bool SP2 = false>
__device__ __forceinline__ void gemm_phase(PG8_LAS unsigned char* lds, const Gemm g, const Sched& S, const Epi& E) {
    int tid_ = threadIdx.x; asm volatile("" : "+v"(tid_));
    const int tid = tid_, wid = __builtin_amdgcn_readfirstlane(tid >> 6), lane = tid & 63, wr = wid >> 2, wc = wid & 3, fr = lane & 15, fq = lane >> 4;
    const int K = g.K, nt = K / BK;
    unsigned voffA[2], voffB[2];
#pragma unroll
    for (int i = 0; i < 2; ++i) { int R, C; stage_rc(tid * 16 + i * 8192, R, C); const int Rb = Epi::PERM ? ((R & ~31) + perm32(R & 31)) : R;
        voffA[i] = (unsigned)(R * K + C) * 2u; voffB[i] = (unsigned)(Rb * K + C) * 2u; }
    const size_t kstep = (size_t)(BK * 2);
    const size_t hstep = (size_t)HALF * K * 2;
    const size_t tstep = 2 * hstep;
    const unsigned ldsw = (unsigned)wid * 1024u;
    const int aoff = lds_byte(wr * 64 + fr, fq * 8), boff = lds_byte(wc * 32 + fr, fq * 8);
#define PG8_SA(b, h) (((b) * 2 + (h)) * HTB)
#define PG8_SB(b, h) ((4 + (b) * 2 + (h)) * HTB)
#define PG8_STAGE(bufoff, gbase, voff) do { _Pragma("unroll") for (int _i = 0; _i < 2; ++_i) \
        __builtin_amdgcn_global_load_lds((const unsigned*)((const char*)(gbase) + (voff)[_i]), (PG8_LAS unsigned*)(lds + (bufoff) + ldsw + _i * 8192), 16, 0, 0); } while (0)
#define PG8_LDA(dst, b, h) do { _Pragma("unroll") for (int m = 0; m < 4; ++m) _Pragma("unroll") for (int k = 0; k < 2; ++k) dst[m][k] = *(const PG8_LAS bf16x8*)(lds + PG8_SA(b, h) + aoff + m * 2048 + k * 1024); } while (0)
#define PG8_LDB(dst, b, h) do { _Pragma("unroll") for (int n = 0; n < 2; ++n) _Pragma("unroll") for (int k = 0; k < 2; ++k) dst[n][k] = *(const PG8_LAS bf16x8*)(lds + PG8_SB(b, h) + boff + n * 2048 + k * 1024); } while (0)
#define PG8_MMA(ai, bj, At, Bt) do { __builtin_amdgcn_s_setprio(1); _Pragma("unroll") for (int m = 0; m < 4; ++m) _Pragma("unroll") for (int n = 0; n < 2; ++n) _Pragma("unroll") for (int k = 0; k < 2; ++k) \
        acc[ai][bj][m][n] = __builtin_amdgcn_mfma_f32_16x16x32_bf16(Bt[n][k], At[m][k], acc[ai][bj][m][n], 0, 0, 0); __builtin_amdgcn_s_setprio(0); } while (0)
#define PG8_WAIT_V(n) asm volatile("s_waitcnt vmcnt(" #n ")" ::: "memory")
#define PG8_WAIT_L(n) asm volatile("s_waitcnt lgkmcnt(" #n ")" ::: "memory")
#define PG8_BAR __builtin_amdgcn_s_barrier()
#define PG8_SCHED __builtin_amdgcn_sched_barrier(0)
    Unit cur, nxt; int ui = 0;
    if (!S.next(0, cur)) return;
    f32x4 acc[2][2][4][2];
#pragma unroll
    for (int a = 0; a < 2; ++a)
#pragma unroll
        for (int b = 0; b < 2; ++b)
#pragma unroll
            for (int m = 0; m < 4; ++m)
#pragma unroll
                for (int n = 0; n < 2; ++n) acc[a][b][m][n] = (f32x4){0.f, 0.f, 0.f, 0.f};
    bf16x8 At[4][2], B0[2][2], B1[2][2];
    const char* cA = (const char*)g.A + (size_t)cur.pm * tstep; const char* cB = (const char*)g.Bt + (size_t)cur.pn * tstep;
    S.a_ready(cur);
    if constexpr (SP2) {
        PG8_STAGE(PG8_SB(0, 0), cB, voffB); PG8_STAGE(PG8_SB(0, 1), cB + hstep, voffB); PG8_STAGE(PG8_SA(0, 0), cA, voffA); PG8_STAGE(PG8_SA(0, 1), cA + hstep, voffA);
        if (wr == 1) PG8_BAR;
        PG8_WAIT_V(2); PG8_BAR;
        PG8_STAGE(PG8_SB(1, 0), cB + kstep, voffB); PG8_STAGE(PG8_SA(1, 0), cA + kstep, voffA); PG8_STAGE(PG8_SB(1, 1), cB + hstep + kstep, voffB);
        PG8_WAIT_V(6); PG8_BAR;
    } else {
        PG8_STAGE(PG8_SB(0, 0), cB, voffB); PG8_STAGE(PG8_SA(0, 0), cA, voffA); PG8_STAGE(PG8_SB(0, 1), cB + hstep, voffB); PG8_STAGE(PG8_SA(0, 1), cA + hstep, voffA);
        if (wr == 1) PG8_BAR;
        PG8_WAIT_V(4); PG8_BAR;
        PG8_STAGE(PG8_SB(1, 0), cB + kstep, voffB); PG8_STAGE(PG8_SA(1, 0), cA + kstep, voffA); PG8_STAGE(PG8_SB(1, 1), cB + hstep + kstep, voffB);
        PG8_WAIT_V(6); PG8_BAR;
    }
    for (;;) {
        const bool has_next = S.next(ui + 1, nxt);
        const char* nA = has_next ? (const char*)g.A + (size_t)nxt.pm * tstep : cA; const char* nB = has_next ? (const char*)g.Bt + (size_t)nxt.pn * tstep : cB;
        for (int t = 0; t < nt; t += 2) {
            const bool last = (t == nt - 2);
            if (last) E.prefetch(cur, wid, lane);
            const char* a1 = cA + (size_t)(t + 1) * kstep;
            const char* a2 = last ? nA : cA + (size_t)(t + 2) * kstep; const char* b2 = last ? nB : cB + (size_t)(t + 2) * kstep;
            const char* a3 = a2 + kstep; const char* b3 = b2 + kstep;
            if (last && has_next) S.a_ready(nxt);
            if constexpr (SP2) {
            PG8_LDB(B0, 0, 0); PG8_LDB(B1, 0, 1); PG8_SCHED; PG8_LDA(At, 0, 0); PG8_STAGE(PG8_SA(1, 1), a1 + hstep, voffA);
            PG8_WAIT_V(8); PG8_WAIT_L(0); PG8_BAR; PG8_MMA(0, 0, At, B0); PG8_MMA(0, 1, At, B1); PG8_BAR; PG8_SCHED;
            PG8_LDA(At, 0, 1); PG8_STAGE(PG8_SB(0, 0), b2, voffB); PG8_STAGE(PG8_SB(0, 1), b2 + hstep, voffB); PG8_STAGE(PG8_SA(0, 0), a2, voffA);
            PG8_WAIT_V(8); PG8_WAIT_L(0); PG8_BAR; PG8_MMA(1, 0, At, B0); PG8_MMA(1, 1, At, B1); PG8_BAR; PG8_SCHED;
            PG8_LDB(B0, 1, 0); PG8_LDB(B1, 1, 1); PG8_SCHED; PG8_LDA(At, 1, 0); PG8_STAGE(PG8_SA(0, 1), a2 + hstep, voffA);
            PG8_WAIT_V(8); PG8_WAIT_L(0); PG8_BAR; PG8_MMA(0, 0, At, B0); PG8_MMA(0, 1, At, B1); PG8_BAR; PG8_SCHED;
            PG8_LDA(At, 1, 1); PG8_STAGE(PG8_SB(1, 0), b3, voffB); PG8_STAGE(PG8_SB(1, 1), b3 + hstep, voffB); PG8_STAGE(PG8_SA(1, 0), a3, voffA);
            PG8_WAIT_V(8); PG8_WAIT_L(0); PG8_BAR; PG8_MMA(1, 0, At, B0); PG8_MMA(1, 1, At, B1); PG8_BAR; PG8_SCHED;
            } else {
            PG8_LDB(B0, 0, 0); PG8_SCHED; PG8_LDA(At, 0, 0); PG8_STAGE(PG8_SA(1, 1), a1 + hstep, voffA);
            PG8_WAIT_L(8); PG8_BAR; PG8_WAIT_L(0); PG8_MMA(0, 0, At, B0); PG8_BAR; PG8_SCHED;
            PG8_LDB(B1, 0, 1); PG8_STAGE(PG8_SB(0, 0), b2, voffB);
            PG8_BAR; PG8_WAIT_L(0); PG8_MMA(0, 1, At, B1); PG8_BAR;
            PG8_LDA(At, 0, 1); PG8_STAGE(PG8_SA(0, 0), a2, voffA);
            PG8_BAR; PG8_WAIT_L(0); PG8_MMA(1, 0, At, B0); PG8_BAR; PG8_SCHED;
            PG8_STAGE(PG8_SB(0, 1), b2 + hstep, voffB);
            PG8_WAIT_V(6); PG8_BAR; PG8_MMA(1, 1, At, B1); PG8_BAR;
            PG8_LDB(B0, 1, 0); PG8_SCHED; PG8_LDA(At, 1, 0); PG8_STAGE(PG8_SA(0, 1), a2 + hstep, voffA);
            PG8_WAIT_L(8); PG8_BAR; PG8_WAIT_L(0); PG8_MMA(0, 0, At, B0); PG8_BAR; PG8_SCHED;
            PG8_LDB(B1, 1, 1); PG8_STAGE(PG8_SB(1, 0), b3, voffB);
            PG8_BAR; PG8_WAIT_L(0); PG8_MMA(0, 1, At, B1); PG8_BAR;
            PG8_LDA(At, 1, 1); PG8_STAGE(PG8_SA(1, 0), a3, voffA);
            PG8_BAR; PG8_WAIT_L(0); PG8_MMA(1, 0, At, B0); PG8_BAR; PG8_SCHED;
            PG8_STAGE(PG8_SB(1, 1), b3 + hstep, voffB);
            PG8_WAIT_V(6); PG8_BAR; PG8_MMA(1, 1, At, B1); PG8_BAR;
            }
        }
        if constexpr (ALIGN_EPI) { if (wr == 0) PG8_BAR; }
        if constexpr (!Epi::AFTER_DRAIN) { E(acc, cur, wr, wc, fr, fq); S.done(cur); }
        if (!has_next) break;
#pragma unroll
        for (int a = 0; a < 2; ++a)
#pragma unroll
            for (int b = 0; b < 2; ++b)
#pragma unroll
                for (int m = 0; m < 4; ++m)
#pragma unroll
                    for (int n = 0; n < 2; ++n) acc[a][b][m][n] = (f32x4){0.f, 0.f, 0.f, 0.f};
        cur = nxt; cA = nA; cB = nB; ++ui;
        if constexpr (ALIGN_EPI) { if (wr == 1) PG8_BAR; }
    }
    PG8_WAIT_V(0);
    if constexpr (!ALIGN_EPI) { if (wr == 0) PG8_BAR; }
    PG8_BAR;
    if constexpr (Epi::AFTER_DRAIN) { E.fused(acc, cur, wr, wc, fr, fq, lds, wid, lane); S.done(cur); }
#undef PG8_SA
#undef PG8_SB
#undef PG8_STAGE
#undef PG8_LDA
#undef PG8_LDB
#undef PG8_MMA
#undef PG8_WAIT_V
#undef PG8_WAIT_L
#undef PG8_BAR
#undef PG8_SCHED
}
}
#include <hip/hip_bf16.h>
#include <cmath>
namespace attn_body {
using bf16=__hip_bfloat16;
using bf16x8=__attribute__((ext_vector_type(8)))short;
using s16x4=__attribute__((ext_vector_type(4)))short;
using f32x16=__attribute__((ext_vector_type(16)))float;
using u32x4=__attribute__((ext_vector_type(4)))unsigned;
constexpr int D=64;
constexpr int NW=8,QBLK=32,QB=QBLK*NW,KVBLK=64;
#define ALAS __attribute__((address_space(3)))
typedef float af32x4 __attribute__((ext_vector_type(4)));
__device__ __forceinline__ int crow(int r,int hi){return (r&3)+8*(r>>2)+4*hi;}
#define SBAR() __builtin_amdgcn_sched_barrier(0)
template<int MODE> __device__ __forceinline__ void bmask(f32x16&p0,f32x16&p1,int t,int qo,int hi){
  const float NEG=-INFINITY; const int kb=64*t+4*hi;
  #pragma unroll
  for(int r=0;r<16;++r){const int kv=kb+(r&3)+8*(r>>2);
    if(MODE==0){ if(kv>qo)p0[r]=NEG; if(kv+32>qo)p1[r]=NEG; }
    else { if(kv>qo||kv<qo-128)p0[r]=NEG; if(kv+32>qo||kv+32<qo-128)p1[r]=NEG; } }
}

template<int MODE> __device__ __forceinline__ void bmask2(f32x16&p0,f32x16&p1,int t,int qo,int qolo,int hi){
  const float NEG=-INFINITY; const int kb=64*t+4*hi;
  if(64*t+63>qolo){
    #pragma unroll
    for(int r=0;r<16;++r){const int kv=kb+(r&3)+8*(r>>2); if(kv>qo)p0[r]=NEG; if(kv+32>qo)p1[r]=NEG; } }
  if(MODE==1&&64*t<qolo-97){
    #pragma unroll
    for(int r=0;r<16;++r){const int kv=kb+(r&3)+8*(r>>2); if(kv<qo-128)p0[r]=NEG; if(kv+32<qo-128)p1[r]=NEG; } }
}

constexpr int NSLOT=3, SLOTB=8192;
constexpr int LDS_K=0, LDS_V=NSLOT*SLOTB, LDS_WS=2*NSLOT*SLOTB, LDS_OST=LDS_WS+NW*64*4, LDS_BYTES=LDS_OST+NW*4096;
constexpr float C2=0.125f*1.4426950408889634f;
__device__ __forceinline__ void glds16(const void*gsrc,unsigned lds_dst){unsigned keep;
  asm volatile("s_mov_b32 %0, m0\n\ts_mov_b32 m0, %2\n\ts_nop 0\n\tglobal_load_lds_dwordx4 %1, off\n\ts_mov_b32 m0, %0":"=&s"(keep):"v"(gsrc),"s"(lds_dst):"memory");}
__device__ __forceinline__ float max3f(float a,float b,float c){float r;asm("v_max3_f32 %0, %1, %2, %3":"=v"(r):"v"(a),"v"(b),"v"(c));return r;}
__device__ __forceinline__ float max2f(float a,float b){float r;asm("v_max_f32_e32 %0, %1, %2":"=v"(r):"v"(a),"v"(b));return r;}
__device__ __forceinline__ float fadd_s(float a,float b){float r;asm("v_add_f32_e32 %0, %1, %2":"=v"(r):"v"(a),"v"(b));return r;}
__device__ __forceinline__ float fsub_s(float a,float b){float r;asm("v_sub_f32_e32 %0, %1, %2":"=v"(r):"v"(a),"v"(b));return r;}
typedef float f32x2_t __attribute__((ext_vector_type(2))); typedef __bf16 bf16x2_t __attribute__((ext_vector_type(2)));
__device__ __forceinline__ unsigned cvtpk_s(float lo,float hi){f32x2_t v={lo,hi};bf16x2_t b=__builtin_convertvector(v,bf16x2_t);return __builtin_bit_cast(unsigned,b);}
#define WAIT_BAR(N) asm volatile("s_waitcnt vmcnt(" #N ") lgkmcnt(0)\n\ts_barrier":::"memory")

__device__ __forceinline__ void qkt(f32x16&p0,f32x16&p1,const char*Kslot,const bf16x8*qr,int r32,int hi){
  const char*kb=Kslot+hi*1024+r32*16;
  #pragma unroll
  for(int d0=0;d0<4;++d0){
    const bf16x8 b0=*reinterpret_cast<const bf16x8*>(kb+d0*2048);
    const bf16x8 b1=*reinterpret_cast<const bf16x8*>(kb+d0*2048+512);
    {p0=__builtin_amdgcn_mfma_f32_32x32x16_bf16(b0,qr[d0],p0,0,0,0);p1=__builtin_amdgcn_mfma_f32_32x32x16_bf16(b1,qr[d0],p1,0,0,0);}}
}
typedef __attribute__((address_space(3))) const char* lds_cptr;
typedef short v4i16_t __attribute__((ext_vector_type(4)));
__device__ __forceinline__ void kload8(bf16x8*kf,lds_cptr kp){
  kf[0]=*(const __attribute__((address_space(3))) bf16x8*)(kp);      kf[1]=*(const __attribute__((address_space(3))) bf16x8*)(kp+512);
  kf[2]=*(const __attribute__((address_space(3))) bf16x8*)(kp+2048); kf[3]=*(const __attribute__((address_space(3))) bf16x8*)(kp+2560);
  kf[4]=*(const __attribute__((address_space(3))) bf16x8*)(kp+4096); kf[5]=*(const __attribute__((address_space(3))) bf16x8*)(kp+4608);
  kf[6]=*(const __attribute__((address_space(3))) bf16x8*)(kp+6144); kf[7]=*(const __attribute__((address_space(3))) bf16x8*)(kp+6656);
}
__device__ __forceinline__ void kload2(bf16x8*kf,lds_cptr kp,int j){ kf[2*j]=*(const __attribute__((address_space(3))) bf16x8*)(kp+j*2048); kf[2*j+1]=*(const __attribute__((address_space(3))) bf16x8*)(kp+j*2048+512); }
__device__ __forceinline__ s16x4 vtr(lds_cptr p){ return __builtin_bit_cast(s16x4,__builtin_amdgcn_ds_read_tr16_b64_v4i16((__attribute__((address_space(3))) v4i16_t*)p)); }
__device__ __forceinline__ float rowmax(const f32x16&p0,const f32x16&p1){
  float a=max3f(p0[0],p0[1],p1[0]),b=max3f(p0[2],p0[3],p1[1]);a=max3f(a,p1[2],p1[3]);
  #pragma unroll
  for(int r=4;r<16;r+=4){a=max3f(a,p0[r],p0[r+1]);b=max3f(b,p0[r+2],p0[r+3]);a=max3f(a,p1[r],p1[r+1]);b=max3f(b,p1[r+2],p1[r+3]);}
  const float m=max2f(a,b);
  auto rr=__builtin_amdgcn_permlane32_swap(__float_as_uint(m),__float_as_uint(m),false,false);
  return max2f(__uint_as_float(rr[0]),__uint_as_float(rr[1]));
}
__device__ __forceinline__ void pv(f32x16*o,int vb,bf16x8 pa0,bf16x8 pa1,bf16x8 pa2,bf16x8 pa3){
  #pragma unroll
  for(int d0=0;d0<2;++d0){s16x4 lo[4],hi[4];
    #pragma unroll
    for(int ks=0;ks<4;++ks){
      asm volatile("ds_read_b64_tr_b16 %0,%1 offset:%c2":"=&v"(lo[ks]):"v"(vb),"i"(d0*4096+ks*1024):"memory");
      asm volatile("ds_read_b64_tr_b16 %0,%1 offset:%c2":"=&v"(hi[ks]):"v"(vb),"i"(d0*4096+ks*1024+512):"memory");}
    asm volatile("s_waitcnt lgkmcnt(0)":::"memory");SBAR();
    #define PK(k) (bf16x8){lo[k][0],lo[k][1],lo[k][2],lo[k][3],hi[k][0],hi[k][1],hi[k][2],hi[k][3]}
    o[d0]=__builtin_amdgcn_mfma_f32_32x32x16_bf16(pa0,PK(0),o[d0],0,0,0);
    o[d0]=__builtin_amdgcn_mfma_f32_32x32x16_bf16(pa1,PK(1),o[d0],0,0,0);
    o[d0]=__builtin_amdgcn_mfma_f32_32x32x16_bf16(pa2,PK(2),o[d0],0,0,0);
    o[d0]=__builtin_amdgcn_mfma_f32_32x32x16_bf16(pa3,PK(3),o[d0],0,0,0);
    #undef PK
  }
}

#ifndef ATTN_STORE16
#define ATTN_STORE16(p,v) (*(u32x4*)(p)=(v))
#endif
#define QIMG_OFF(w) ((w)<7?100352+4096*(w):131328)
template<int MODE,int THRL,bool COMB=false,bool NOMAX=false> __device__ __forceinline__ void attn_unit(const bf16*Qp,const bf16*Kp,const bf16*Vp,bf16*Op,long P,int NT,int qoff,const ALAS float*cumL,float*lsep,long lse_stride,char*shm,bool pre,const bf16*Qn,const bf16*Kn,long Pn,bf16*mixp=nullptr,long mix_stride=0,long lse_gstride=0,long o_gstride=0){
  int tid_=threadIdx.x; asm volatile("":"+v"(tid_)); const int tid=tid_,lane=tid&63,r32=lane&31,hi=lane>>5; const int wid=__builtin_amdgcn_readfirstlane(tid>>6);
  const bf16*Qw=Qp+(long)(wid*QBLK)*P;
  const bf16*Kh=Kp,*Vh=Vp;
  const unsigned lds0=(unsigned)(uintptr_t)shm;
  float*wsf=(float*)(shm+LDS_WS)+wid*64;
  const bf16*ksrc=Kh+(long)lane*P+wid*8;
  const bf16*vsrc=Vh+(long)(16*(wid&3)+(lane>>2))*P+(wid>>2)*32+(lane&3)*8;
  const unsigned kdst=lds0+LDS_K+wid*1024, vdst=lds0+LDS_V+wid*1024;
  #define DMA_K(t,slot) glds16(ksrc+(long)(t)*KVBLK*P,(unsigned)__builtin_amdgcn_readfirstlane(kdst+(slot)))
  #define DMA_V(t,slot) glds16(vsrc+(long)(t)*KVBLK*P,(unsigned)__builtin_amdgcn_readfirstlane(vdst+(slot)))
  const int vb0=(int)(lds0+LDS_V)+((lane>>4)&1)*32+(lane&3)*8+(4*hi+((lane&15)>>2))*64;
  const char*Kbase=shm+LDS_K; bf16x8 kf[8];
  const lds_cptr shm3=(lds_cptr)shm; const lds_cptr kp0=shm3+LDS_K+hi*1024+r32*16; const lds_cptr vp0=shm3+LDS_V+((lane>>4)&1)*32+(lane&3)*8+(4*hi+((lane&15)>>2))*64;
  if(!pre){DMA_K(0,0);
    { const bf16*q0_=Qp+(long)(wid*QBLK+(lane>>3))*P+(lane&7)*8;
      _Pragma("unroll") for(int pc_=0;pc_<4;++pc_)glds16(q0_+(long)(8*pc_)*P,(unsigned)__builtin_amdgcn_readfirstlane(lds0+QIMG_OFF(wid)+1024*pc_)); }
    DMA_V(0,0);DMA_K(1,SLOTB);}else{DMA_V(0,0);}
  bf16x8 qr[4];
  float mhat=0.f,l_reg=0.f;f32x16 o[2];o[0]=f32x16{};o[1]=f32x16{};
  const int qrel=wid*QBLK+r32, qo=qrel+qoff;
  const int qolo=wid*QBLK+qoff; const int t_lo=(MODE==1)?(((qolo-128)>0?(qolo-128):0)>>6):0; const int t_hi=(qolo+31)>>6;
  const float cq2=(MODE==0)?cumL[qo]:0.f; float qb=cq2;
  #define CMASK(P0,P1,t) do{ if(MODE==1||(t)>=NT-4)bmask2<MODE>(P0,P1,(t),qo,qolo,hi); }while(0)
  #define BIASFILL(C0,C1,t) do{ if(MODE==0){ const ALAS float*cp_=cumL+64*(t)+4*hi; \
      _Pragma("unroll") for(int g_=0;g_<4;++g_){ const af32x4 a_=*(const ALAS af32x4*)(cp_+8*g_), b_=*(const ALAS af32x4*)(cp_+32+8*g_); \
        C0[4*g_]=qb-a_.x;C0[4*g_+1]=qb-a_.y;C0[4*g_+2]=qb-a_.z;C0[4*g_+3]=qb-a_.w; C1[4*g_]=qb-b_.x;C1[4*g_+1]=qb-b_.y;C1[4*g_+2]=qb-b_.z;C1[4*g_+3]=qb-b_.w; } } \
    else if(!NOMAX){ _Pragma("unroll") for(int r_=0;r_<16;++r_){C0[r_]=qb;C1[r_]=qb;} } }while(0)
  #define CIN(C) ((NOMAX&&MODE==1)?f32x16{}:(C))
  bool resc=false;
  #define START(P0,P1) do{ resc=false; if(!NOMAX){ const float rm=rowmax(P0,P1); \
    { const float dl=__builtin_fmaxf(rm,-64.f); mhat=fadd_s(mhat,dl); qb=cq2-mhat; \
      _Pragma("unroll") for(int r=0;r<16;++r){P0[r]=fsub_s(P0[r],dl);P1[r]=fsub_s(P1[r],dl);} \
      } } \
    _Pragma("unroll") for(int r=0;r<16;++r)P0[r]=__builtin_amdgcn_exp2f(P0[r]); }while(0)
  #define RESC() do{ if(resc){ asm volatile("s_waitcnt lgkmcnt(0)":::"memory"); \
      _Pragma("unroll") for(int d_=0;d_<2;++d_) _Pragma("unroll") for(int r=0;r<16;++r)o[d_][r]*=wsf[crow(r,hi)]; } }while(0)
  f32x16 pA0,pA1,pB0,pB1;
  int sl_prev=0,sl_cur=0,sl_next=SLOTB;
  #define ROT() do{sl_prev=sl_cur;sl_cur=sl_next;sl_next=(sl_next==(NSLOT-1)*SLOTB)?0:sl_next+SLOTB;}while(0)
  if(!pre){DMA_K(2,2*SLOTB);
    WAIT_BAR(3);}
  else{WAIT_BAR(1);}
  {
    const ALAS char*qimg_=(const ALAS char*)(shm3+QIMG_OFF(wid))+r32*128+hi*16;
    _Pragma("unroll") for(int d0=0;d0<4;++d0)qr[d0]=*(const ALAS bf16x8*)(qimg_+d0*32); }
  asm volatile("s_waitcnt lgkmcnt(0)":::"memory");
  if(0)WAIT_BAR(3);
  if(MODE==1&&t_lo>0){ pA0=f32x16{}; pA1=f32x16{}; resc=false; }
  else{
  BIASFILL(pA0,pA1,0); if(NOMAX&&MODE==1){pA0=f32x16{};pA1=f32x16{};} qkt(pA0,pA1,Kbase,qr,r32,hi);asm volatile("s_nop 15\n\ts_nop 7":"+v"(pA0),"+v"(pA1));CMASK(pA0,pA1,0);
  START(pA0,pA1);
  _Pragma("unroll") for(int r=0;r<16;++r)pA1[r]=__builtin_amdgcn_exp2f(pA1[r]);
  }
  WAIT_BAR(0);
  DMA_K(3,0);DMA_V(1,SLOTB);
  ROT();
  kload8(kf,kp0+sl_cur);
  WAIT_BAR(2);
  s16x4 vlo[8],vhi[8]; u32x4 pw0,pw1,pw2,pw3;
  #define PKW(P,B) cvtpk_s(P[B],P[B+1])
  #define PAF(k) __builtin_bit_cast(bf16x8,pw##k)
  #define VFR(i) (bf16x8){vlo[i][0],vlo[i][1],vlo[i][2],vlo[i][3],vhi[i][0],vhi[i][1],vhi[i][2],vhi[i][3]}
  #define PIN(x) asm volatile("":"+v"(x))
  #define MX3(a,b,c) __builtin_fmaxf(__builtin_fmaxf((a),(b)),(c))
  #define GAPA(MF,A0,A1,A2,A3,W0,W1,PW) do{ MF; sacc+=A0; sacc+=A1; sacc+=A2; sacc+=A3; PIN(sacc); W0; W1; PIN(PW); SBAR(); }while(0)
  #define EX(v) __builtin_amdgcn_exp2f(v)
  #define GAPB(MF,X,B) do{ MF; X[B]=EX(X[B]); X[B+1]=EX(X[B+1]); X[B+2]=EX(X[B+2]); X[B+3]=EX(X[B+3]); PIN(X); SBAR(); }while(0)
  #define VRD(i) do{ vlo[i]=vtr(vp_+(((i)>>2)*4096+((i)&3)*1024)); vhi[i]=vtr(vp_+(((i)>>2)*4096+((i)&3)*1024+512)); }while(0)
  #define KRD(G,j) do{ if(G){ kload2(kf,kp0+sl_next,j); SBAR(); } }while(0)
  #define STEP(C0,C1,P0,P1,t,GK,GV,GL) do{ SBAR(); BIASFILL(C0,C1,t); SBAR(); \
    const lds_cptr vp_=vp0+sl_prev; \
    VRD(0); SBAR(); float sacc=(P0[0]+P0[1]); \
    GAPA(C0=__builtin_amdgcn_mfma_f32_32x32x16_bf16(kf[0],qr[0],CIN(C0),0,0,0), P0[2],P0[3],P0[4],P0[5],     pw0[0]=PKW(P0,0), pw0[1]=PKW(P0,2), pw0); \
    VRD(4); SBAR(); GAPA(C1=__builtin_amdgcn_mfma_f32_32x32x16_bf16(kf[1],qr[0],CIN(C1),0,0,0), P0[6],P0[7],P0[8],P0[9],     pw0[2]=PKW(P0,4), pw0[3]=PKW(P0,6), pw0); \
    VRD(1); SBAR(); GAPA(C0=__builtin_amdgcn_mfma_f32_32x32x16_bf16(kf[2],qr[1],C0,0,0,0),   P0[10],P0[11],P0[12],P0[13], pw1[0]=PKW(P0,8), pw1[1]=PKW(P0,10), pw1); \
    VRD(5); SBAR(); GAPA(C1=__builtin_amdgcn_mfma_f32_32x32x16_bf16(kf[3],qr[1],C1,0,0,0),   P0[14],P0[15],P1[0],P1[1],   pw1[2]=PKW(P0,12),pw1[3]=PKW(P0,14), pw1); \
    VRD(2); SBAR(); GAPA(C0=__builtin_amdgcn_mfma_f32_32x32x16_bf16(kf[4],qr[2],C0,0,0,0),   P1[2],P1[3],P1[4],P1[5],     pw2[0]=PKW(P1,0), pw2[1]=PKW(P1,2), pw2); \
    VRD(6); SBAR(); GAPA(C1=__builtin_amdgcn_mfma_f32_32x32x16_bf16(kf[5],qr[2],C1,0,0,0),   P1[6],P1[7],P1[8],P1[9],     pw2[2]=PKW(P1,4), pw2[3]=PKW(P1,6), pw2); \
    VRD(3); SBAR(); GAPA(C0=__builtin_amdgcn_mfma_f32_32x32x16_bf16(kf[6],qr[3],C0,0,0,0),   P1[10],P1[11],P1[12],P1[13], pw3[0]=PKW(P1,8), pw3[1]=PKW(P1,10), pw3); \
    VRD(7); SBAR(); GAPA(C1=__builtin_amdgcn_mfma_f32_32x32x16_bf16(kf[7],qr[3],C1,0,0,0),   P1[14],P1[15],0.f,0.f,       pw3[2]=PKW(P1,12),pw3[3]=PKW(P1,14), pw3); \
    l_reg+=sacc; \
    if(GK){DMA_K((t)+3,sl_cur);} if(GV){DMA_V((t)+1,sl_next);} \
    CMASK(C0,C1,t); resc=false; \
    if(!NOMAX){ float a=MX3(C0[0],C0[1],C1[0]),b=MX3(C0[2],C0[3],C1[1]); a=MX3(a,C1[2],C1[3]); \
      _Pragma("unroll") for(int r=4;r<16;r+=4){a=MX3(a,C0[r],C0[r+1]);b=MX3(b,C0[r+2],C0[r+3]);a=MX3(a,C1[r],C1[r+1]);b=MX3(b,C1[r+2],C1[r+3]);} \
      float rm=__builtin_fmaxf(a,b); { auto rr=__builtin_amdgcn_permlane32_swap(__float_as_uint(rm),__float_as_uint(rm),false,false); rm=__builtin_fmaxf(__uint_as_float(rr[0]),__uint_as_float(rr[1])); } \
      resc=false; \
      if(__builtin_expect(__any(rm>(float)THRL),0)){ const float dl=__builtin_fmaxf(rm,0.f); mhat+=dl; \
        _Pragma("unroll") for(int r=0;r<16;++r){C0[r]-=dl;C1[r]-=dl;} \
        qb=cq2-mhat; \
        const float f=__builtin_amdgcn_exp2f(-dl); l_reg*=f; if(hi==0)wsf[r32]=f; resc=true; } } \
    SBAR(); \
    GAPB(o[0]=__builtin_amdgcn_mfma_f32_32x32x16_bf16(PAF(0),VFR(0),o[0],0,0,0), C0,0); \
    GAPB(o[1]=__builtin_amdgcn_mfma_f32_32x32x16_bf16(PAF(0),VFR(4),o[1],0,0,0), C0,4); \
    KRD(GL,0); GAPB(o[0]=__builtin_amdgcn_mfma_f32_32x32x16_bf16(PAF(1),VFR(1),o[0],0,0,0), C0,8); \
    KRD(GL,1); GAPB(o[1]=__builtin_amdgcn_mfma_f32_32x32x16_bf16(PAF(1),VFR(5),o[1],0,0,0), C0,12); \
    KRD(GL,2); GAPB(o[0]=__builtin_amdgcn_mfma_f32_32x32x16_bf16(PAF(2),VFR(2),o[0],0,0,0), C1,0); \
    KRD(GL,3); GAPB(o[1]=__builtin_amdgcn_mfma_f32_32x32x16_bf16(PAF(2),VFR(6),o[1],0,0,0), C1,4); \
    GAPB(o[0]=__builtin_amdgcn_mfma_f32_32x32x16_bf16(PAF(3),VFR(3),o[0],0,0,0), C1,8); \
    GAPB(o[1]=__builtin_amdgcn_mfma_f32_32x32x16_bf16(PAF(3),VFR(7),o[1],0,0,0), C1,12); \
    }while(0)
  #define XSTEP(C0,C1,P0,P1,t,GK,GV,GL) do{ const int t_=(t); if(t_>=t_lo&&t_<=t_hi+1){ STEP(C0,C1,P0,P1,t,GK,GV,GL); } \
    else{ if(GK){DMA_K(t_+3,sl_cur);} if(GV){DMA_V(t_+1,sl_next);} if(GL){kload8(kf,kp0+sl_next);} \
      _Pragma("unroll") for(int r_=0;r_<16;++r_){C0[r_]=0.f;C1[r_]=0.f;} resc=false; } }while(0)
  int t=1;
  #undef CMASK
  #define CMASK(P0,P1,t) do{}while(0)
  for(;t+5<NT;t+=2){
    STEP(pB0,pB1,pA0,pA1,t,true,true,true);     WAIT_BAR(2); RESC(); ROT();
    STEP(pA0,pA1,pB0,pB1,t+1,true,true,true);   WAIT_BAR(2); RESC(); ROT();
  }
  #undef CMASK
  #define CMASK(P0,P1,t) do{ if(MODE==1||(t)>=NT-4)bmask2<MODE>(P0,P1,(t),qo,qolo,hi); }while(0)
  #define ENDW(tt) do{ if((tt)+3<NT){WAIT_BAR(2);} else if((tt)+2<NT){WAIT_BAR(1);} else {WAIT_BAR(0);} }while(0)
  for(;t+1<NT;t+=2){
    STEP(pB0,pB1,pA0,pA1,t,(t+3<NT),(t+1<NT),(t+1<NT));       ENDW(t);   RESC(); ROT();
    STEP(pA0,pA1,pB0,pB1,t+1,(t+4<NT),(t+2<NT),(t+2<NT));     ENDW(t+1); RESC(); ROT();
  }
  if(Kn){ const bf16*kn_=Kn+(long)lane*Pn+wid*8;
    glds16(kn_,(unsigned)__builtin_amdgcn_readfirstlane(kdst)); glds16(kn_+(long)KVBLK*Pn,(unsigned)__builtin_amdgcn_readfirstlane(kdst+SLOTB)); glds16(kn_+(long)2*KVBLK*Pn,(unsigned)__builtin_amdgcn_readfirstlane(kdst+2*SLOTB));
    const bf16*qn_=Qn+(long)(wid*QBLK+(lane>>3))*Pn+(lane&7)*8;
    _Pragma("unroll") for(int pc_=0;pc_<4;++pc_)glds16(qn_+(long)(8*pc_)*Pn,(unsigned)__builtin_amdgcn_readfirstlane(lds0+QIMG_OFF(wid)+1024*pc_)); }
  STEP(pB0,pB1,pA0,pA1,NT-1,false,false,false); RESC();
  { float sacc=pB0[0]+pB0[1]; _Pragma("unroll") for(int r=2;r<16;++r)sacc+=pB0[r]; _Pragma("unroll") for(int r=0;r<16;++r)sacc+=pB1[r]; l_reg+=sacc;
    pw0=(u32x4){PKW(pB0,0),PKW(pB0,2),PKW(pB0,4),PKW(pB0,6)};pw1=(u32x4){PKW(pB0,8),PKW(pB0,10),PKW(pB0,12),PKW(pB0,14)};pw2=(u32x4){PKW(pB1,0),PKW(pB1,2),PKW(pB1,4),PKW(pB1,6)};pw3=(u32x4){PKW(pB1,8),PKW(pB1,10),PKW(pB1,12),PKW(pB1,14)};
    SBAR(); pv(o,vb0+sl_cur,PAF(0),PAF(1),PAF(2),PAF(3)); }
  SBAR();
  SBAR();
  #undef PKW
  #undef PAF
  #undef VFR
  #undef PIN
  #undef MX3
  #undef GAPA
  #undef GAPB
  #undef EX
  #undef VRD
  #undef KRD
  #undef STEP
  #undef XSTEP
  #undef ENDW
  {auto rr=__builtin_amdgcn_permlane32_swap(__float_as_uint(l_reg),__float_as_uint(l_reg),false,false);l_reg=__uint_as_float(rr[0])+__uint_as_float(rr[1]);}
  const float lse2_=mhat+__builtin_amdgcn_logf(l_reg);
  if(MODE==1&&!COMB&&hi==0)lsep[(long)qrel*lse_stride]=lse2_;
  if(COMB&&hi==0)wsf[r32]=lse2_;
  if(hi==0)wsf[32+r32]=l_reg;asm volatile("s_waitcnt lgkmcnt(0)":::"memory");
  float rli[16];
  #pragma unroll
  for(int r=0;r<16;++r)rli[r]=__builtin_amdgcn_rcpf(wsf[32+crow(r,hi)]);
  bf16*Ow=Op+(long)(wid*QBLK)*P;
  { bf16*stg=(bf16*)(shm+LDS_OST)+wid*2048;
    #pragma unroll
    for(int r=0;r<16;++r){const int orow=crow(r,hi);
      #pragma unroll
      for(int d0=0;d0<2;++d0)stg[orow*64+d0*32+r32]=__float2bfloat16(o[d0][r]*rli[r]);}
    asm volatile("s_waitcnt lgkmcnt(0)":::"memory");
    if(!COMB){
      #pragma unroll
      for(int i=0;i<4;++i){const int row=i*8+(lane>>3),ch=lane&7; const u32x4 v=*(const u32x4*)(stg+row*64+ch*8); ATTN_STORE16(Ow+(long)row*P+ch*8,v);} }
    else{
      const int ch=lane&7; u32x4 a0[4],a1[4]; float l0[4],l1[4];
      #pragma unroll
      for(int i=0;i<4;++i){const int row=i*8+(lane>>3); const bf16*o0p=Ow-2*o_gstride+(long)row*P+ch*8; a0[i]=*(const u32x4*)o0p; a1[i]=*(const u32x4*)(o0p+o_gstride);
        const long lr=(long)(wid*QBLK+row)*lse_stride; l0[i]=lsep[lr-2*lse_gstride]; l1[i]=lsep[lr-lse_gstride]; }
      #pragma unroll
      for(int i=0;i<4;++i){const int row=i*8+(lane>>3); const u32x4 v=*(const u32x4*)(stg+row*64+ch*8); const float l2=wsf[row];
        const float mx=__builtin_fmaxf(l0[i],__builtin_fmaxf(l1[i],l2)); float w0=__builtin_amdgcn_exp2f(l0[i]-mx), w1=__builtin_amdgcn_exp2f(l1[i]-mx), w2=__builtin_amdgcn_exp2f(l2-mx);
        const float inv=__builtin_amdgcn_rcpf(w0+w1+w2); w0*=inv; w1*=inv; w2*=inv; u32x4 y;
        #pragma unroll
        for(int k=0;k<4;++k){ const float lo=w0*__uint_as_float(a0[i][k]<<16)+w1*__uint_as_float(a1[i][k]<<16)+w2*__uint_as_float(v[k]<<16);
          const float hh=w0*__uint_as_float(a0[i][k]&0xffff0000u)+w1*__uint_as_float(a1[i][k]&0xffff0000u)+w2*__uint_as_float(v[k]&0xffff0000u); y[k]=cvtpk_s(lo,hh); }
        *(u32x4*)(mixp+(long)(wid*QBLK+row)*mix_stride+ch*8)=y; } } }
  asm volatile("s_waitcnt lgkmcnt(0)\n\ts_barrier":::"memory");
  #undef DMA_K
  #undef DMA_V
  #undef CMASK
  #undef START
  #undef RESC
  #undef ROT
  #undef BIASFILL
  #undef CIN
}
constexpr int ATTN_LDS_BYTES=LDS_BYTES;
#undef SBAR
#undef WAIT_BAR
}
#define LAS __attribute__((address_space(3)))
typedef unsigned short bf16;
typedef float f32x4 __attribute__((ext_vector_type(4)));
typedef short bf16x8 __attribute__((ext_vector_type(8)));
typedef unsigned v4u __attribute__((ext_vector_type(4)));
typedef unsigned v2u __attribute__((ext_vector_type(2)));

constexpr int DM = 1024, NB = 16, SEQ = 4096, M = NB * SEQ, FF = 2816, FF2 = 2 * FF, NH = 16, NQKV = 9216, HALF_M = M / 2;
constexpr float EPS = 1e-6f, LOG2E = 1.4426950408889634f, C2 = 0.125f * 1.4426950408889634f;
constexpr int NWAVES = 8, NTHREADS = 512, LDS_BYTES = 148480, LDS_SS_OFF = 131072 + 256;
constexpr size_t MiB = 1u << 20;
constexpr size_t WS_WIN = 2 * MiB, WIN_SZ = (size_t)FF2 * DM * 2;
constexpr size_t WS_WOUT = WS_WIN + 4 * WIN_SZ, WOUT_SZ = (size_t)DM * FF * 2;
constexpr size_t WS_WQKV = WS_WOUT + 4 * WOUT_SZ;
constexpr size_t WS_WAO = WS_WQKV + (size_t)NQKV * DM * 2, WS_WKV = WS_WAO + 2 * MiB, WS_WBQ = WS_WKV + 5 * MiB, WS_WBO = WS_WBQ + 2 * MiB, WS_WEND = WS_WBO + 2 * MiB;
static_assert(WS_WEND <= 98 * MiB, "weights");
constexpr size_t WS_BAR = 0, CTL_ZERO_BYTES = 16384;
constexpr size_t WS_ROPE = 98 * MiB, WS_LOGF = 102 * MiB, WS_CUM = 106 * MiB, WS_LSE = 110 * MiB, WS_SS = 116 * MiB;
constexpr size_t WS_XN = 128 * MiB, WS_MIX = 256 * MiB, WS_BIG = 384 * MiB;
constexpr size_t WS_ACT = WS_BIG, WS_QKV = WS_BIG, WS_XN2 = 736 * MiB, WS_QB = 736 * MiB, WS_KB = 256 * MiB, WS_VB = 864 * MiB, WS_END = 992 * MiB;
static_assert(WS_ACT + (size_t)M * FF * 2 <= WS_XN2 && WS_QKV + (size_t)HALF_M * NQKV * 2 <= WS_END, "map");

struct Params {
    const float* x; const int* pos; const float* ffn_norm; const float* ffn_w_in; const float* ffn_w_out; const float* mix_norm;
    const float* a_w_qkv; const float* a_q_norm; const float* a_k_norm; const float* a_w_o; const float* kv_norm; const float* kv_w;
    const float* kv_b_f; const float* kv_k_norm; const float* b_w_q; const float* b_q_norm; const float* b_w_o;
    float* out; unsigned char* ws;
    float invf[8];
};

__device__ __forceinline__ unsigned f2bf(float f) { unsigned u = __builtin_bit_cast(unsigned, f); return (u + 0x7fffu + ((u >> 16) & 1u)) >> 16; }
__device__ __forceinline__ unsigned pk2(float lo, float hi) { return f2bf(lo) | (f2bf(hi) << 16); }
__device__ __forceinline__ float bf2f(short h) { return __uint_as_float(((unsigned)(unsigned short)h) << 16); }
__device__ __forceinline__ float wave_sum(float v) {
#pragma unroll
    for (int o = 1; o < 64; o <<= 1) v += __shfl_xor(v, o);
    return v;
}
#define LDS_WAIT() asm volatile("s_waitcnt lgkmcnt(0)" ::: "memory")

#define XB_TMO      128
#define XB_XCNT(j)  (256  + 64 * (j))
#define XB_XSUB(j)  (1280 + 64 * (j))
#define XB_XGEN(j)  (2304 + 64 * (j))
#define XB_TOP      3328
#define XB_TOPGEN   3392
#define XCD_BAR_WORDS 3456
#define XB_SPIN_CAP (1u << 18)

__device__ __forceinline__ unsigned xb_ld(unsigned* p)              { return __hip_atomic_load(p, __ATOMIC_RELAXED, __HIP_MEMORY_SCOPE_AGENT); }
__device__ __forceinline__ unsigned xb_add(unsigned* p, unsigned v) { return __hip_atomic_fetch_add(p, v, __ATOMIC_RELAXED, __HIP_MEMORY_SCOPE_AGENT); }
__device__ __forceinline__ unsigned xb_xcc_id() { return (unsigned)__builtin_amdgcn_s_getreg((3 << 11) | 20) & 0xFu; }
#define XB_SPIN(cond, bar) do { unsigned _sp = 0; while (cond) { __builtin_amdgcn_s_sleep(1); \
    if ((++_sp & 255u) == 0u) { if (xb_ld(&(bar)[XB_TMO])) break; if (_sp > XB_SPIN_CAP) { atomicAdd(&(bar)[XB_TMO], 1u); break; } } } } while (0)

struct XcdBarrier {
    unsigned* bar; unsigned x;
    volatile LAS unsigned* st;
};

__device__ __forceinline__ XcdBarrier xcd_barrier_post(unsigned* bar, volatile LAS unsigned* st) {
    XcdBarrier b; b.bar = bar; b.x = xb_xcc_id(); b.st = st;
    if (threadIdx.x == 0) (void)xb_add(&bar[XB_XCNT(b.x)], 1u);
    return b;
}
__device__ __forceinline__ void xcd_barrier_complete(unsigned* bar, unsigned x, unsigned& nloc, unsigned& nx) {
    const unsigned G = gridDim.x * gridDim.y * gridDim.z;
    unsigned sum, cnt, mine, sp = 0u;
    for (;;) {
        sum = 0u; cnt = 0u; mine = 0u;
#pragma unroll
        for (unsigned j = 0; j < 16; ++j) { const unsigned c = xb_ld(&bar[XB_XCNT(j)]); sum += c; cnt += (c > 0u) ? 1u : 0u; mine = (j == x) ? c : mine; }
        if (sum == G) break;
        __builtin_amdgcn_s_sleep(1);
        if ((++sp & 255u) == 0u) { if (xb_ld(&bar[XB_TMO])) break; if (sp > XB_SPIN_CAP) { atomicAdd(&bar[XB_TMO], 1u); break; } }
    }
    nloc = mine > 0u ? mine : 1u; nx = cnt > 0u ? cnt : 1u;
}

__device__ __forceinline__ void xcd_barrier(const XcdBarrier& b) {
    asm volatile("s_waitcnt vmcnt(0)" ::: "memory");
    __syncthreads();
    if (threadIdx.x == 0) {
        unsigned* bar = b.bar;
        __builtin_amdgcn_s_waitcnt(0);
        unsigned nloc = b.st[0], nx = b.st[1];
        if (nloc == 0u) { xcd_barrier_complete(bar, b.x, nloc, nx); b.st[0] = nloc; b.st[1] = nx; }
        const unsigned old = xb_add(&bar[XB_XSUB(b.x)], 1u);
        const unsigned gen = old / nloc;
        if (old + 1u == (gen + 1u) * nloc) {
            __builtin_amdgcn_fence(__ATOMIC_RELEASE, "agent");
            asm volatile("s_waitcnt vmcnt(0)" ::: "memory");
            const unsigned og = xb_add(&bar[XB_TOP], 1u);
            const unsigned tg = og / nx;
            if (og + 1u == (tg + 1u) * nx) xb_add(&bar[XB_TOPGEN], 1u);
            else XB_SPIN(xb_ld(&bar[XB_TOPGEN]) == tg, bar);
            __builtin_amdgcn_fence(__ATOMIC_ACQUIRE, "agent");
            xb_add(&bar[XB_XGEN(b.x)], 1u);
            asm volatile("s_waitcnt vmcnt(0)" ::: "memory");
        } else {
            XB_SPIN(xb_ld(&bar[XB_XGEN(b.x)]) == gen, bar);
            __builtin_amdgcn_fence(__ATOMIC_ACQUIRE, "agent");
            asm volatile("s_waitcnt vmcnt(0)" ::: "memory");
        }
    }
    __syncthreads();
}

__device__ __forceinline__ void tr_item(const float* W, int ldw, int K, bf16* WT, int dst0, int src0, int k0, const float* gain, int nvalid, float wscale, LAS float* scr, int lane) {
#pragma unroll 8
    for (int i = 0; i < 32; ++i) { const int kk = 2 * i + (lane >> 5); float v = ((lane & 31) < nvalid) ? W[(size_t)(k0 + kk) * ldw + src0 + (lane & 31)] : 0.f; if (gain) v *= gain[k0 + kk]; scr[kk * 33 + (lane & 31)] = v * wscale; }
    LDS_WAIT(); asm volatile("" ::: "memory");
    const int c = lane & 7;
#pragma unroll
    for (int j = 0; j < 4; ++j) { const int n = (lane >> 3) + 8 * j; const LAS float* s = scr + (8 * c) * 33 + n;
        v4u o; o.x = pk2(s[0 * 33], s[1 * 33]); o.y = pk2(s[2 * 33], s[3 * 33]); o.z = pk2(s[4 * 33], s[5 * 33]); o.w = pk2(s[6 * 33], s[7 * 33]);
        *(v4u*)(WT + (size_t)(dst0 + n) * K + k0 + 8 * c) = o; }
    LDS_WAIT(); asm volatile("" ::: "memory");
}
__device__ __forceinline__ int srcmap(int kind, int c0) {
    const int pn = c0 >> 8, p = c0 & 255;
    if (kind == 1) return (p >> 7) * FF + 128 * pn + (p & 127);
    if (kind == 2) return 256 * pn + 64 * ((p >> 5) & 3) + 32 * (p >> 7);
    return c0;
}
__device__ __forceinline__ bool tr_matrix(int& it, const float* W, int ldw, int K, int ndst, bf16* WT, int kind, const float* gain, LAS float* scr, int lane) {
    const int nblk = ndst / 32, nit = (K / 64) * nblk;
    if (it >= nit) { it -= nit; return false; }
    const int kb = it / nblk, nb = it % nblk;
    int src0 = srcmap(kind == 3 ? 2 : kind, 32 * nb), nvalid = 32;
    if (kind == 3 && nb >= 64) { src0 = (nb == 64) ? 2048 : 0; nvalid = (nb == 64) ? 16 : 0; }
    const float wscale = (kind == 1) ? ((((32 * nb) >> 7) & 1) ? (1.0f / LOG2E) : LOG2E) : 1.0f;
    tr_item(W, ldw, K, WT, 32 * nb, src0, 64 * kb, gain, nvalid, wscale, scr, lane);
    return true;
}

__device__ __forceinline__ void norm_rows(const float* src, const float* g, bf16* dst, int gw, int NGW, int lane) {
    f32x4 gv[4];
#pragma unroll
    for (int j = 0; j < 4; ++j) gv[j] = *(const f32x4*)(g + 4 * lane + 256 * j);
    for (int m = gw; m < M; m += NGW) {
        const f32x4* xr = (const f32x4*)(src + (size_t)m * DM) + lane; f32x4 v[4]; float s = 0.f;
#pragma unroll
        for (int j = 0; j < 4; ++j) { v[j] = xr[64 * j]; s += (v[j].x * v[j].x + v[j].y * v[j].y) + (v[j].z * v[j].z + v[j].w * v[j].w); }
        const float rstd = 1.0f / sqrtf(wave_sum(s) * (1.0f / DM) + EPS);
        v2u* o8 = (v2u*)(dst + (size_t)m * DM) + lane;
#pragma unroll
        for (int j = 0; j < 4; ++j) { const f32x4 y = v[j] * rstd * gv[j]; v2u w; w.x = pk2(y.x, y.y); w.y = pk2(y.z, y.w); o8[64 * j] = w; }
    }
}

struct BandUnit { bf16* q; bf16* k; bf16* v; long P; int NT, qoff, g, head; size_t row0; };
__device__ __forceinline__ BandUnit band_unit(int un, bf16* QKV, int gmode) {
    BandUnit r; const int uu = un & 15, head = (un >> 4) & 15, rest = un >> 8, g = gmode ? 2 : (rest & 1), bl = gmode ? rest : (rest >> 1);
    const int dil = (g == 0) ? 1 : (g == 1) ? 4 : 16, L = SEQ / dil;
    const int mglob = uu * 256, res = mglob / L, m0 = mglob % L;
    const int kb0 = m0 ? m0 - 128 : 0; r.NT = m0 ? 6 : 4; r.qoff = m0 ? 128 : 0; r.P = (long)dil * 64; r.g = g; r.head = head;
    bf16* base = QKV + ((size_t)((bl * 3 + g) * 3) * 16 + head) * (size_t)(SEQ * 64) + (size_t)res * 64;
    constexpr size_t WHICH = (size_t)16 * SEQ * 64;
    r.q = base + (size_t)m0 * r.P; r.k = base + WHICH + (size_t)kb0 * r.P; r.v = base + 2 * WHICH + (size_t)kb0 * r.P;
    r.row0 = (size_t)bl * SEQ + res + (size_t)m0 * dil;
    return r;
}
enum Op { OP_PRO = 0, OP_NORM, OP_FFN1, OP_FFN2, OP_QKV, OP_ATTA, OP_COMB, OP_WOA, OP_NORMKV, OP_KVFFN1, OP_QB, OP_FOX, OP_WOB };
constexpr int NPH = 19;

__global__ void __launch_bounds__(NTHREADS, 2) fwd_kernel(Params p) {
    extern __shared__ __attribute__((aligned(16))) unsigned char lds_raw[];
    cg::grid_group grid = cg::this_grid();
    LAS unsigned char* lds = (LAS unsigned char*)lds_raw;
    const int G = gridDim.x, bx = blockIdx.x;
    const int vcu = (G % 8 == 0) ? (bx % 8) * (G / 8) + bx / 8 : bx;
    const int NGW = G * NWAVES;
    unsigned char* ws = p.ws;
    bf16* XN = (bf16*)(ws + WS_XN); bf16* XN2 = (bf16*)(ws + WS_XN2); bf16* MIX = (bf16*)(ws + WS_MIX); bf16* ACT = (bf16*)(ws + WS_ACT); bf16* QKV = (bf16*)(ws + WS_QKV);
    bf16* QB = (bf16*)(ws + WS_QB); bf16* KB = (bf16*)(ws + WS_KB); bf16* VB = (bf16*)(ws + WS_VB);
    float* ROPE = (float*)(ws + WS_ROPE); float* LOGF = (float*)(ws + WS_LOGF); float* CUM = (float*)(ws + WS_CUM); float* LSE = (float*)(ws + WS_LSE); float* SS = (float*)(ws + WS_SS);
    float* out = p.out;
    if (threadIdx.x < 64) ((LAS unsigned*)(lds + 131072))[threadIdx.x] = 0u;
    __syncthreads();
    const XcdBarrier xbar = xcd_barrier_post((unsigned*)(ws + WS_BAR), (volatile LAS unsigned*)(lds + 131072) + 8);

#pragma unroll 1
    for (int ph = 0; ph < NPH; ++ph) {
        int tid = threadIdx.x; asm volatile("" : "+v"(tid));
        const int lane = tid & 63, wave = __builtin_amdgcn_readfirstlane(tid >> 6), gw = vcu * NWAVES + wave;
        int op, a = 0;
        switch (ph) {
            case 0: op = OP_PRO; break;
            case 1: op = OP_FFN1; a = 0; break;   case 2: op = OP_FFN2; a = 0; break;
            case 3: op = OP_QKV; a = 0; break;    case 4: op = OP_ATTA; a = 0; break;   case 5: op = OP_COMB; a = 0; break;
            case 6: op = OP_QKV; a = 1; break;    case 7: op = OP_ATTA; a = 1; break;   case 8: op = OP_COMB; a = 1; break;
            case 9: op = OP_WOA; break;
            case 10: op = OP_FFN1; a = 1; break;  case 11: op = OP_FFN2; a = 1; break;
            case 12: op = OP_KVFFN1; a = 2; break; case 13: op = OP_FFN2; a = 2; break;
            case 14: op = OP_QB; break;           case 15: op = OP_FOX; break;          case 16: op = OP_WOB; break;
            case 17: op = OP_FFN1; a = 3; break;  default: op = OP_FFN2; a = 3; break;
        }
        if (op == OP_PRO) {
            LAS float* scr = (LAS float*)(lds + wave * 16384);
            constexpr int I_IN = (DM / 64) * (FF2 / 32), I_OUT = (FF / 64) * (DM / 32), I_QKV = (DM / 64) * (NQKV / 32), I_SQ = (DM / 64) * (DM / 32), I_KV = (DM / 64) * (2304 / 32);
            constexpr int NITEMS = 4 * I_IN + 4 * I_OUT + I_QKV + 3 * I_SQ + I_KV;
            for (int it0 = gw; it0 < NITEMS; it0 += NGW) {
                int it = it0; bool done = false;
#pragma unroll 1
                for (int i = 0; i < 4 && !done; ++i) done = tr_matrix(it, p.ffn_w_in + (size_t)i * DM * FF2, FF2, DM, FF2, (bf16*)(ws + WS_WIN + i * WIN_SZ), 1, p.ffn_norm + i * DM, scr, lane);
#pragma unroll 1
                for (int i = 0; i < 4 && !done; ++i) done = tr_matrix(it, p.ffn_w_out + (size_t)i * FF * DM, DM, FF, DM, (bf16*)(ws + WS_WOUT + i * WOUT_SZ), 0, nullptr, scr, lane);
                if (!done) done = tr_matrix(it, p.a_w_qkv, NQKV, DM, NQKV, (bf16*)(ws + WS_WQKV), 2, p.mix_norm, scr, lane);
                if (!done) done = tr_matrix(it, p.a_w_o, DM, DM, DM, (bf16*)(ws + WS_WAO), 0, nullptr, scr, lane);
                if (!done) done = tr_matrix(it, p.kv_w, 2064, DM, 2304, (bf16*)(ws + WS_WKV), 3, p.kv_norm, scr, lane);
                if (!done) done = tr_matrix(it, p.b_w_q, DM, DM, DM, (bf16*)(ws + WS_WBQ), 2, p.mix_norm + DM, scr, lane);
                if (!done) done = tr_matrix(it, p.b_w_o, DM, DM, DM, (bf16*)(ws + WS_WBO), 0, nullptr, scr, lane);
            }
            for (int m = bx * NTHREADS + tid; m < M; m += G * NTHREADS) {
                const float pf = (float)p.pos[m]; float cs[16];
#pragma unroll
                for (int f = 0; f < 8; ++f) { const float ang = pf * p.invf[f];
                    double r = (double)ang * 0.15915494309189535; r -= floor(r); const float rf = (float)r;
                    cs[f] = __builtin_amdgcn_cosf(rf); cs[8 + f] = __builtin_amdgcn_sinf(rf); }
#pragma unroll
                for (int f = 0; f < 4; ++f) *(f32x4*)(ROPE + (size_t)m * 16 + 4 * f) = (f32x4){cs[4 * f], cs[4 * f + 1], cs[4 * f + 2], cs[4 * f + 3]};
            }
            for (int mrow = gw; mrow < M; mrow += NGW) {
                const f32x4* xr = (const f32x4*)(p.x + (size_t)mrow * DM) + lane; f32x4 v[4]; float s = 0.f;
#pragma unroll
                for (int j = 0; j < 4; ++j) { v[j] = xr[64 * j]; s += (v[j].x * v[j].x + v[j].y * v[j].y) + (v[j].z * v[j].z + v[j].w * v[j].w); }
                s = wave_sum(s);
                v2u* o8 = (v2u*)(XN + (size_t)mrow * DM) + lane;
#pragma unroll
                for (int j = 0; j < 4; ++j) { v2u w; w.x = pk2(v[j].x, v[j].y); w.y = pk2(v[j].z, v[j].w); o8[64 * j] = w; }
                if (lane < 16) SS[(size_t)mrow * 16 + lane] = (lane == 0) ? s : 0.f;
            }
        }
        if (op == OP_QKV || op == OP_KVFFN1 || op == OP_QB) {
            pg8::Gemm g; pg8::EpiHead E;
            if (op == OP_QKV) { g = pg8::Gemm{XN + (size_t)a * HALF_M * DM, (const bf16*)(ws + WS_WQKV), HALF_M, NQKV, DM};
                E = pg8::EpiHead{QKV, nullptr, NQKV, p.a_q_norm, p.a_k_norm, ROPE, a * HALF_M, 0, C2, SS, nullptr, nullptr, (LAS float*)(lds + LDS_SS_OFF)}; }
            else if (op == OP_KVFFN1) { g = pg8::Gemm{XN, (const bf16*)(ws + WS_WKV), M, 2304, DM};
                E = pg8::EpiHead{KB, VB, DM, nullptr, p.kv_k_norm, ROPE, 0, 1, 1.0f, SS, p.kv_b_f, LOGF, (LAS float*)(lds + LDS_SS_OFF)}; }
            else { g = pg8::Gemm{XN, (const bf16*)(ws + WS_WBQ), M, DM, DM};
                E = pg8::EpiHead{QB, nullptr, DM, p.b_q_norm, nullptr, ROPE, 0, 2, C2, SS, nullptr, nullptr, (LAS float*)(lds + LDS_SS_OFF)}; }
            pg8::StaticOrder S; S.init(g.M, g.N, G, bx);
#ifndef NO_HEAD
            pg8::gemm_phase<pg8::EpiHead, pg8::StaticOrder, true, true>(lds, g, S, E);
#endif
        }
        if (ph == 13) {
#ifndef NO_SCAN
            if (wave == 0) for (int sidx = vcu; sidx < NB * NH; sidx += G) {
                const int b = sidx >> 4, h = sidx & 15; const float* src = LOGF + ((size_t)b * SEQ + 64 * lane) * 16 + h;
                float v[64]; float tot = 0.f;
#pragma unroll
                for (int i = 0; i < 64; ++i) v[i] = src[(size_t)i * 16];
#pragma unroll
                for (int i = 0; i < 64; ++i) tot += v[i];
                float inc = tot;
#pragma unroll
                for (int o = 1; o < 64; o <<= 1) { const float t = __shfl_up(inc, o); if (lane >= o) inc += t; }
                float run = inc - tot; float* dst = CUM + (size_t)sidx * SEQ + 64 * lane;
#pragma unroll
                for (int i = 0; i < 64; i += 4) { f32x4 o4; run += v[i]; o4.x = run * LOG2E; run += v[i + 1]; o4.y = run * LOG2E; run += v[i + 2]; o4.z = run * LOG2E; run += v[i + 3]; o4.w = run * LOG2E; *(f32x4*)(dst + i) = o4; }
            }
#endif
        }
        if (op == OP_FFN1 || op == OP_KVFFN1) {
            pg8::Gemm g{XN, (const bf16*)(ws + WS_WIN + a * WIN_SZ), M, FF2, DM};
            pg8::StaticOrder S; S.init(M, FF2, G, bx); pg8::EpiSwiglu E{ACT, FF, SS, (LAS float*)(lds + LDS_SS_OFF)};
#ifndef NO_SWI
            pg8::gemm_phase<pg8::EpiSwiglu, pg8::StaticOrder, true, true>(lds, g, S, E);
#endif
        }
        if (op == OP_FFN2 || op == OP_WOA || op == OP_WOB) {
            pg8::Gemm g; pg8::EpiResF32 E;
            if (op == OP_FFN2) { g = pg8::Gemm{ACT, (const bf16*)(ws + WS_WOUT + a * WOUT_SZ), M, DM, FF}; E = (ph == 2) ? pg8::EpiResF32{p.x, nullptr, nullptr, XN, DM, 0.5f, SS} : (ph == NPH - 1) ? pg8::EpiResF32{nullptr, XN, out, nullptr, DM, 0.5f, SS} : pg8::EpiResF32{nullptr, XN, nullptr, XN, DM, 0.5f, SS}; }
            else if (op == OP_WOA) { g = pg8::Gemm{MIX, (const bf16*)(ws + WS_WAO), M, DM, DM}; E = pg8::EpiResF32{nullptr, XN, nullptr, XN, DM, 1.0f, SS}; }
            else { g = pg8::Gemm{QB, (const bf16*)(ws + WS_WBO), M, DM, DM}; E = pg8::EpiResF32{nullptr, XN, nullptr, XN, DM, 1.0f, SS}; }
            pg8::StaticOrder S; S.init(M, DM, G, bx);
#ifndef NO_RES
            pg8::gemm_phase<pg8::EpiResF32, pg8::StaticOrder, true, true>(lds, g, S, E);
#endif
        }
#ifndef NO_ATTA
        bool band_nomax = false;
        if (op == OP_ATTA || op == OP_COMB) {
            float gq = 0.f, gk = 0.f;
            for (int d = 0; d < 192; ++d) { gq = fmaxf(gq, fabsf(p.a_q_norm[d])); gk = fmaxf(gk, fabsf(p.a_k_norm[d])); }
            band_nomax = (C2 * 64.0f * gq * gk * 1.03f + 0.5f) < 60.0f;
        }
        if (op == OP_ATTA) {
            constexpr int NU = 8 * 2 * 16 * 16;
            bool pre = false;
            for (int un = vcu; un < NU; un += G) {
#define BAND_ROT(u_) ((G & 15) ? (u_) : (((u_) & ~15) | (((u_) + (u_) / G) & 15)))
                BandUnit cu_ = band_unit(BAND_ROT(un), QKV, 0), nx_ = band_unit(BAND_ROT(un + G < NU ? un + G : un), QKV, 0); const bool has_next = un + G < NU;
                float* lse = LSE + ((size_t)cu_.g * HALF_M + cu_.row0) * 16 + cu_.head;
                if (band_nomax) attn_body::attn_unit<1, 8, false, true>((const attn_body::bf16*)cu_.q, (const attn_body::bf16*)cu_.k, (const attn_body::bf16*)cu_.v, (attn_body::bf16*)cu_.q, cu_.P, cu_.NT, cu_.qoff, nullptr, lse, cu_.P / 4, (char*)lds_raw,
                                           pre, has_next ? (const attn_body::bf16*)nx_.q : nullptr, has_next ? (const attn_body::bf16*)nx_.k : nullptr, nx_.P);
                else attn_body::attn_unit<1, 8>((const attn_body::bf16*)cu_.q, (const attn_body::bf16*)cu_.k, (const attn_body::bf16*)cu_.v, (attn_body::bf16*)cu_.q, cu_.P, cu_.NT, cu_.qoff, nullptr, lse, cu_.P / 4, (char*)lds_raw,
                                           pre, has_next ? (const attn_body::bf16*)nx_.q : nullptr, has_next ? (const attn_body::bf16*)nx_.k : nullptr, nx_.P);
                pre = has_next;
            }
        }
        if (op == OP_COMB) {
            constexpr int NU = 8 * 16 * 16;
            bool pre = false;
            for (int un = vcu; un < NU; un += G) {
                BandUnit cu_ = band_unit(un, QKV, 1), nx_ = band_unit(un + G < NU ? un + G : un, QKV, 1); const bool has_next = un + G < NU;
                float* lse = LSE + ((size_t)2 * HALF_M + cu_.row0) * 16 + cu_.head;
                bf16* mixp = MIX + ((size_t)a * HALF_M + cu_.row0) * DM + cu_.head * 64;
                if (band_nomax) attn_body::attn_unit<1, 8, true, true>((const attn_body::bf16*)cu_.q, (const attn_body::bf16*)cu_.k, (const attn_body::bf16*)cu_.v, (attn_body::bf16*)cu_.q, cu_.P, cu_.NT, cu_.qoff, nullptr, lse, cu_.P / 4, (char*)lds_raw,
                                                 pre, has_next ? (const attn_body::bf16*)nx_.q : nullptr, has_next ? (const attn_body::bf16*)nx_.k : nullptr, nx_.P,
                                                 (attn_body::bf16*)mixp, cu_.P * 16, (long)HALF_M * 16, (long)3 * 16 * SEQ * 64);
                else attn_body::attn_unit<1, 8, true>((const attn_body::bf16*)cu_.q, (const attn_body::bf16*)cu_.k, (const attn_body::bf16*)cu_.v, (attn_body::bf16*)cu_.q, cu_.P, cu_.NT, cu_.qoff, nullptr, lse, cu_.P / 4, (char*)lds_raw,
                                                 pre, has_next ? (const attn_body::bf16*)nx_.q : nullptr, has_next ? (const attn_body::bf16*)nx_.k : nullptr, nx_.P,
                                                 (attn_body::bf16*)mixp, cu_.P * 16, (long)HALF_M * 16, (long)3 * 16 * SEQ * 64);
                pre = has_next;
            }
        }
#endif
#ifndef NO_FOX
        if (op == OP_FOX) {
            LAS float* cumL = (LAS float*)(lds + attn_body::ATTN_LDS_BYTES);
            float gqm = 0.f, gkm = 0.f;
            for (int d = 0; d < 64; ++d) { gqm = fmaxf(gqm, fabsf(p.b_q_norm[d])); gkm = fmaxf(gkm, fabsf(p.kv_k_norm[d])); }
            const float skip_thr = -(160.0f + 2.0f * (C2 * 64.0f * gqm * gkm * 1.03f + 0.5f));
            const bool fox_nomax = (C2 * 64.0f * gqm * gkm * 1.03f + 0.5f) < 60.0f;
            for (int sidx = vcu; sidx < NB * NH; sidx += G) {
                for (int i = tid; i < SEQ / 4; i += NTHREADS) ((LAS f32x4*)cumL)[i] = ((const f32x4*)(CUM + (size_t)sidx * SEQ))[i];
                __syncthreads();
                const int b = sidx >> 4, h = sidx & 15; const size_t base = (size_t)b * SEQ * DM + h * 64;
                bool pre = false;
                int ts_cur; { const int NT = 64, q0 = 15 * 256; int ts = 0; const float cq0 = cumL[q0];
                    while (ts + 2 <= NT - 4 && cq0 - cumL[64 * (ts + 2) - 1] < skip_thr) ts += 2;
                    ts_cur = __builtin_amdgcn_readfirstlane(ts); }
#pragma unroll 1
                for (int qb = 15; qb >= 0; --qb) {
                    bf16* qp = QB + base + (size_t)qb * 256 * DM;
                    const int NT = 4 * qb + 4, q0 = qb * 256, ts = ts_cur;
                    int ts_n = 0; const bool has_next = qb > 0;
                    if (has_next) { const int NTn = 4 * qb, q0n = (qb - 1) * 256; const float cq0 = cumL[q0n];
                        while (ts_n + 2 <= NTn - 4 && cq0 - cumL[64 * (ts_n + 2) - 1] < skip_thr) ts_n += 2;
                        ts_n = __builtin_amdgcn_readfirstlane(ts_n); }
                    const size_t ko = (size_t)ts * 64 * DM, kon = (size_t)ts_n * 64 * DM;
                    if (fox_nomax) attn_body::attn_unit<0, 8, false, true>((const attn_body::bf16*)qp, (const attn_body::bf16*)(KB + base + ko), (const attn_body::bf16*)(VB + base + ko), (attn_body::bf16*)qp, (long)DM, NT - ts, q0 - 64 * ts,
                                               cumL + 64 * ts, nullptr, 0, (char*)lds_raw, pre,
                                               has_next ? (const attn_body::bf16*)(qp - (size_t)256 * DM) : nullptr, has_next ? (const attn_body::bf16*)(KB + base + kon) : nullptr, (long)DM);
                    else attn_body::attn_unit<0, 8>((const attn_body::bf16*)qp, (const attn_body::bf16*)(KB + base + ko), (const attn_body::bf16*)(VB + base + ko), (attn_body::bf16*)qp, (long)DM, NT - ts, q0 - 64 * ts,
                                               cumL + 64 * ts, nullptr, 0, (char*)lds_raw, pre,
                                               has_next ? (const attn_body::bf16*)(qp - (size_t)256 * DM) : nullptr, has_next ? (const attn_body::bf16*)(KB + base + kon) : nullptr, (long)DM);
                    pre = has_next; ts_cur = ts_n;
                }
                __syncthreads();
            }
        }
#endif
        if (ph + 1 < NPH) { if (ph == 0) grid.sync(); else xcd_barrier(xbar); }
    }
}

extern "C" void kernel_launch(void* const* d_in, const int* in_sizes, int n_in, void* d_out, int out_size, void* d_ws, size_t ws_size, hipStream_t stream) {
    static int grid = 0;
    if (grid == 0) {
        if (n_in != 17 || in_sizes[0] != M * DM || out_size != M * DM || ws_size < WS_END) { fprintf(stderr, "kernel_launch: unexpected shapes/workspace (n_in %d, ws %zu)\n", n_in, ws_size); grid = -1; return; }
        int dev = 0, cus = 0;
        if (hipGetDevice(&dev) != hipSuccess || hipDeviceGetAttribute(&cus, hipDeviceAttributeMultiprocessorCount, dev) != hipSuccess) { grid = -1; return; }
        if (hipFuncSetAttribute((const void*)fwd_kernel, hipFuncAttributeMaxDynamicSharedMemorySize, LDS_BYTES) != hipSuccess) { fprintf(stderr, "kernel_launch: hipFuncSetAttribute failed\n"); grid = -1; return; }
        int per_cu = 0;
        if (hipOccupancyMaxActiveBlocksPerMultiprocessor(&per_cu, (const void*)fwd_kernel, NTHREADS, LDS_BYTES) != hipSuccess || per_cu < 1) { fprintf(stderr, "kernel_launch: occupancy query says %d\n", per_cu); per_cu = 1; }
        (void)hipGetLastError();
        grid = cus;
    }
    if (grid < 0) return;
    Params p{};
    p.x = (const float*)d_in[0]; p.pos = (const int*)d_in[1]; p.ffn_norm = (const float*)d_in[2]; p.ffn_w_in = (const float*)d_in[3]; p.ffn_w_out = (const float*)d_in[4];
    p.mix_norm = (const float*)d_in[5]; p.a_w_qkv = (const float*)d_in[6]; p.a_q_norm = (const float*)d_in[7]; p.a_k_norm = (const float*)d_in[8]; p.a_w_o = (const float*)d_in[9];
    p.kv_norm = (const float*)d_in[10]; p.kv_w = (const float*)d_in[11]; p.kv_b_f = (const float*)d_in[12]; p.kv_k_norm = (const float*)d_in[13];
    p.b_w_q = (const float*)d_in[14]; p.b_q_norm = (const float*)d_in[15]; p.b_w_o = (const float*)d_in[16];
    p.out = (float*)d_out; p.ws = (unsigned char*)d_ws;
    for (int i = 0; i < 8; ++i) p.invf[i] = (float)pow(500000.0, -(double)i / 8.0);
    if (hipMemsetAsync(d_ws, 0, CTL_ZERO_BYTES, stream) != hipSuccess) { fprintf(stderr, "kernel_launch: memset failed\n"); return; }
    void* args[] = {&p};
    hipError_t e = hipLaunchCooperativeKernel((const void*)fwd_kernel, dim3(grid), dim3(NTHREADS), args, LDS_BYTES, stream);
    if (e != hipSuccess) fprintf(stderr, "kernel_launch: cooperative launch failed: %s (grid %d)\n", hipGetErrorString(e), grid);
}
```
